# Optimizing an MI355X kernel written in HIP

```python
import math
import jax, jax.numpy as jnp
from jax import lax
import numpy as np

D_MODEL = 1024
BATCH = 2
SEQ = 8192
DEPTH = 1

MIX_WIDTH = D_MODEL
ATTN_WIDTH = MIX_WIDTH // 2
CONV_WIDTH = MIX_WIDTH - ATTN_WIDTH
N_DIFF_HEADS = 4
DIFF_HEAD_DIM = ATTN_WIDTH // (2 * N_DIFF_HEADS)
V_HEAD_DIM = 2 * DIFF_HEAD_DIM
IN_PROJ_WIDTH = 3 * ATTN_WIDTH + 3 * CONV_WIDTH
CONV_K = 3
N_BUCKETS = 32
MAX_DISTANCE = 128
Q_BLOCK = 128
N_GROUPS = 4
EXPERTS_PER_GROUP = 4
N_EXPERTS = N_GROUPS * EXPERTS_PER_GROUP
TOP_K = 2
D_EXPERT = D_MODEL // 2
NORM_EPS = 1e-6
SUBLN_EPS = 1e-5
NEG_INF = -1e30

kernel_name = "hybrid_diffattn_shortconv_hmoe_adaln"


def rmsnorm(x, g, eps=NORM_EPS):
    xf = x.astype(jnp.float32)
    y = xf * lax.rsqrt(jnp.mean(xf * xf, axis=-1, keepdims=True) + eps) * g.astype(jnp.float32)
    return y.astype(x.dtype)


def lambda_init_fn(layer_idx):
    return 0.8 - 0.6 * math.exp(-0.3 * layer_idx)


def rel_bucket(n):
    n = jnp.maximum(n, 0)
    max_exact = N_BUCKETS // 2
    is_small = n < max_exact
    nf = jnp.maximum(n, 1).astype(jnp.float32)
    large = max_exact + (jnp.log(nf / max_exact) / math.log(MAX_DISTANCE / max_exact)
                         * (N_BUCKETS - max_exact)).astype(jnp.int32)
    large = jnp.minimum(large, N_BUCKETS - 1)
    return jnp.where(is_small, n, large)


def diff_attention(q, k, v, positions, rel_bias, lq1, lk1, lq2, lk2, subln_g, lam_init):
    B, S, _ = q.shape
    H2 = 2 * N_DIFF_HEADS
    qh = q.reshape(B, S, H2, DIFF_HEAD_DIM).transpose(0, 2, 1, 3).astype(jnp.float32)
    kh = k.reshape(B, S, H2, DIFF_HEAD_DIM).transpose(0, 2, 1, 3).astype(jnp.float32)
    vh = v.reshape(B, S, N_DIFF_HEADS, V_HEAD_DIM).transpose(0, 2, 1, 3).astype(jnp.float32)
    lam = (jnp.exp(jnp.sum(lq1.astype(jnp.float32) * lk1.astype(jnp.float32)))
           - jnp.exp(jnp.sum(lq2.astype(jnp.float32) * lk2.astype(jnp.float32))) + lam_init)
    scale = DIFF_HEAD_DIM ** -0.5
    nb = S // Q_BLOCK
    q_blk = qh.reshape(B, H2, nb, Q_BLOCK, DIFF_HEAD_DIM).transpose(2, 0, 1, 3, 4)
    pos_blk = positions.reshape(B, nb, Q_BLOCK).transpose(1, 0, 2)
    starts = jnp.arange(nb, dtype=jnp.int32) * Q_BLOCK
    kidx = jnp.arange(S, dtype=jnp.int32)
    bias_table = rel_bias.astype(jnp.float32).T

    def block(args):
        qb, pq, s0 = args
        logits = jnp.einsum('bhqd,bhkd->bhqk', qb, kh) * scale
        bucket = rel_bucket(pq[:, :, None] - positions[:, None, :])
        bias = jnp.take(bias_table, bucket, axis=1).transpose(1, 0, 2, 3)
        qidx = s0 + jnp.arange(Q_BLOCK, dtype=jnp.int32)
        causal = kidx[None, :] <= qidx[:, None]
        logits = jnp.where(causal[None, None], logits + bias, NEG_INF)
        p = jax.nn.softmax(logits, axis=-1).reshape(B, N_DIFF_HEADS, 2, Q_BLOCK, S)
        a = p[:, :, 0] - lam * p[:, :, 1]
        return jnp.einsum('bhqk,bhkv->bhqv', a, vh)

    o = lax.map(block, (q_blk, pos_blk, starts))
    o = o.transpose(1, 0, 3, 2, 4).reshape(B, S, N_DIFF_HEADS, V_HEAD_DIM)
    o = o * lax.rsqrt(jnp.mean(o * o, axis=-1, keepdims=True) + SUBLN_EPS)
    o = o * subln_g.astype(jnp.float32) * (1.0 - lam_init)
    return o.reshape(B, S, ATTN_WIDTH).astype(q.dtype)


def short_conv(gate_b, gate_c, h_in, conv_w):
    u = gate_c * h_in
    conv = lax.conv_general_dilated(
        u, conv_w[:, None, :].astype(u.dtype), window_strides=(1,), padding=[(CONV_K - 1, 0)],
        dimension_numbers=('NWC', 'WIO', 'NWC'), feature_group_count=CONV_WIDTH)
    return gate_b * conv


def hier_moe(h, rgw, rgb, rew, reb, w_gate, w_up, w_down):
    B, S, D = h.shape
    ht = h.reshape(B * S, D)
    glog = (ht @ rgw + rgb).astype(jnp.float32)
    pg = jax.nn.softmax(glog, axis=-1)
    gsel = jnp.argmax(glog, axis=-1)
    pg_sel = jnp.take_along_axis(pg, gsel[:, None], axis=1)[:, 0]
    elog = (ht @ rew + reb).astype(jnp.float32).reshape(-1, N_GROUPS, EXPERTS_PER_GROUP)
    sel = jnp.take_along_axis(elog, gsel[:, None, None], axis=1)[:, 0]
    vals, idx = lax.top_k(sel, TOP_K)
    w = jax.nn.softmax(vals, axis=-1) * pg_sel[:, None]
    eid = gsel[:, None] * EXPERTS_PER_GROUP + idx
    gates = jnp.einsum('tkn,tk->tn', jax.nn.one_hot(eid, N_EXPERTS, dtype=jnp.float32), w)
    y = jnp.zeros((B * S, D), jnp.float32)
    for e in range(N_EXPERTS):
        hid = jax.nn.silu(ht @ w_gate[e]) * (ht @ w_up[e])
        y = y + gates[:, e:e + 1] * (hid @ w_down[e]).astype(jnp.float32)
    return y.astype(h.dtype).reshape(B, S, D)


def setup_inputs(seed: int = 0) -> dict:
    key = jax.random.key(seed)
    ks = jax.random.split(key, 24)
    L, D = DEPTH, D_MODEL
    nrm = lambda k, shape, s: jax.random.normal(k, shape, jnp.float32) * s
    return {
        "x": nrm(ks[0], (BATCH, SEQ, D), 1.0),
        "c": nrm(ks[1], (BATCH, D), 1.0),
        "positions": (jnp.arange(SEQ, dtype=jnp.int32)[None, :]
                      + jax.random.randint(ks[2], (BATCH, 1), 0, 4096, dtype=jnp.int32)),
        "rel_bias": nrm(ks[3], (N_BUCKETS, 2 * N_DIFF_HEADS), 0.5),
        "ada_w": nrm(ks[4], (L, D, 6 * D), 0.5 * D ** -0.5),
        "ada_b": nrm(ks[5], (L, 6 * D), 0.02),
        "norm1_g": 1.0 + nrm(ks[6], (L, D), 0.02),
        "w_in": nrm(ks[7], (L, D, IN_PROJ_WIDTH), D ** -0.5),
        "lambda_q1": nrm(ks[8], (L, DIFF_HEAD_DIM), 0.1),
        "lambda_k1": nrm(ks[9], (L, DIFF_HEAD_DIM), 0.1),
        "lambda_q2": nrm(ks[10], (L, DIFF_HEAD_DIM), 0.1),
        "lambda_k2": nrm(ks[11], (L, DIFF_HEAD_DIM), 0.1),
        "subln_g": 1.0 + nrm(ks[12], (L, V_HEAD_DIM), 0.02),
        "conv_w": nrm(ks[13], (L, CONV_K, CONV_WIDTH), CONV_K ** -0.5),
        "w_out": nrm(ks[14], (L, MIX_WIDTH, D), MIX_WIDTH ** -0.5),
        "norm2_g": 1.0 + nrm(ks[15], (L, D), 0.02),
        "router_group_w": nrm(ks[16], (L, D, N_GROUPS), D ** -0.5),
        "router_group_b": nrm(ks[17], (L, N_GROUPS), 0.01),
        "router_expert_w": nrm(ks[18], (L, D, N_EXPERTS), D ** -0.5),
        "router_expert_b": nrm(ks[19], (L, N_EXPERTS), 0.01),
        "expert_w_gate": nrm(ks[20], (L, N_EXPERTS, D, D_EXPERT), D ** -0.5),
        "expert_w_up": nrm(ks[21], (L, N_EXPERTS, D, D_EXPERT), D ** -0.5),
        "expert_w_down": nrm(ks[22], (L, N_EXPERTS, D_EXPERT, D), D_EXPERT ** -0.5),
        "final_g": 1.0 + nrm(ks[23], (D,), 0.02),
    }


def reference(x, c, positions, rel_bias, ada_w, ada_b, norm1_g, w_in, lambda_q1, lambda_k1,
              lambda_q2, lambda_k2, subln_g, conv_w, w_out, norm2_g, router_group_w,
              router_group_b, router_expert_w, router_expert_b, expert_w_gate, expert_w_up,
              expert_w_down, final_g):
    A, C = ATTN_WIDTH, CONV_WIDTH
    split_pts = [A, 2 * A, 3 * A, 3 * A + C, 3 * A + 2 * C]
    for l in range(DEPTH):
        lam_init = lambda_init_fn(l)
        ada = jax.nn.silu(c) @ ada_w[l] + ada_b[l]
        sh1, sc1, g1, sh2, sc2, g2 = jnp.split(ada[:, None, :], 6, axis=-1)
        h = rmsnorm(x, norm1_g[l]) * (1.0 + sc1) + sh1
        proj = h @ w_in[l]
        q, k, v, gb, gc, hc = jnp.split(proj, split_pts, axis=-1)
        attn = diff_attention(q, k, v, positions, rel_bias, lambda_q1[l], lambda_k1[l],
                              lambda_q2[l], lambda_k2[l], subln_g[l], lam_init)
        conv = short_conv(gb, gc, hc, conv_w[l])
        mix = jnp.concatenate([attn, conv], axis=-1) @ w_out[l]
        x = x + g1 * mix
        h = rmsnorm(x, norm2_g[l]) * (1.0 + sc2) + sh2
        x = x + g2 * hier_moe(h, router_group_w[l], router_group_b[l], router_expert_w[l],
                              router_expert_b[l], expert_w_gate[l], expert_w_up[l],
                              expert_w_down[l])
    return rmsnorm(x, final_g)
```

```cpp
#include <hip/hip_runtime.h>
#include <cstdio>
#include <cstdint>
#include <cmath>

constexpr int BATCH = 2, SEQ = 8192, DM = 1024, T = BATCH * SEQ, NPROJ = 3072, NE = 16, DE = 512;
constexpr float LOG2E = 1.4426950408889634f;
constexpr float C2 = 0.125f * LOG2E;

constexpr size_t MiB = 1u << 20;
constexpr size_t WS_CTL = 0, CTL_ZERO_BYTES = 1 * MiB;
constexpr size_t WS_WIN = 2 * MiB;
constexpr size_t WS_WOUT = 8 * MiB;
constexpr size_t WS_WGU = 10 * MiB;
constexpr size_t WS_WD = 42 * MiB;
constexpr size_t WS_SMALL = 58 * MiB;
constexpr size_t WS_LIST = 60 * MiB;
constexpr size_t WS_TOKW = 61 * MiB;
constexpr size_t WS_ACT = 64 * MiB;
constexpr size_t WS_PROJ = 96 * MiB;
constexpr size_t WS_Y = 192 * MiB;
constexpr size_t WS_END = 256 * MiB;
constexpr int CW_NONAFF = 64;
constexpr int CW_CNT = 1024;
constexpr int CW_BAR = 4096;

constexpr int RING_BYTES = 131072;
constexpr int LDSCTL_OFF = RING_BYTES, MISC_OFF = LDSCTL_OFF + 320, TAB_OFF = LDSCTL_OFF + 512;
constexpr int LDS_BYTES = 147456;

#define GAS __attribute__((address_space(1)))
#define LAS __attribute__((address_space(3)))
typedef unsigned short bf16;
typedef unsigned v4u __attribute__((ext_vector_type(4)));
typedef unsigned v2u __attribute__((ext_vector_type(2)));
typedef float f32x4 __attribute__((ext_vector_type(4)));
typedef float f32x2 __attribute__((ext_vector_type(2)));
typedef float f32x16 __attribute__((ext_vector_type(16)));
typedef short bf16x8 __attribute__((ext_vector_type(8)));
typedef short s16x4 __attribute__((ext_vector_type(4)));
#define RLX_AGENT __ATOMIC_RELAXED, __HIP_MEMORY_SCOPE_AGENT
#define LDS_WAIT() asm volatile("s_waitcnt lgkmcnt(0)" ::: "memory")
#define VM_WAIT() asm volatile("s_waitcnt vmcnt(0)" ::: "memory")
__device__ __forceinline__ unsigned f2bf(float f) { unsigned u = __builtin_bit_cast(unsigned, f); return (u + 0x7fffu + ((u >> 16) & 1u)) >> 16; }
__device__ __forceinline__ unsigned pk2(float lo, float hi) { return f2bf(lo) | (f2bf(hi) << 16); }
__device__ __forceinline__ float bf_lo(unsigned w) { return __builtin_bit_cast(float, w << 16); }
__device__ __forceinline__ float bf_hi(unsigned w) { return __builtin_bit_cast(float, w & 0xffff0000u); }
__device__ __forceinline__ float ld_f32_agent(const float* p) { return __builtin_bit_cast(float, __hip_atomic_load((const unsigned*)p, RLX_AGENT)); }
__device__ __forceinline__ int ld_i32_agent(const int* p) { return (int)__hip_atomic_load((const unsigned*)p, RLX_AGENT); }

#define XB_TMO      128
#define XB_XCNT(j)  (256  + 64 * (j))
#define XB_XSUB(j)  (1280 + 64 * (j))
#define XB_XGEN(j)  (2304 + 64 * (j))
#define XB_TOP      3328
#define XB_TOPGEN   3392
#define XCD_BAR_WORDS 3456
#define XB_SPIN_CAP (1u << 18)
__device__ __forceinline__ unsigned xb_ld(unsigned* p)              { return __hip_atomic_load(p, __ATOMIC_RELAXED, __HIP_MEMORY_SCOPE_AGENT); }
__device__ __forceinline__ unsigned xb_add(unsigned* p, unsigned v) { return __hip_atomic_fetch_add(p, v, __ATOMIC_RELAXED, __HIP_MEMORY_SCOPE_AGENT); }
__device__ __forceinline__ unsigned xb_xcc_id() { return (unsigned)__builtin_amdgcn_s_getreg((3 << 11) | 20) & 0xFu; }
#define XB_SPIN(cond, bar) do { unsigned _sp = 0; while (cond) { __builtin_amdgcn_s_sleep(1); \
    if ((++_sp & 255u) == 0u) { if (xb_ld(&(bar)[XB_TMO])) break; if (_sp > XB_SPIN_CAP) { atomicAdd(&(bar)[XB_TMO], 1u); break; } } } } while (0)
struct XcdBarrier { unsigned* bar; unsigned x; volatile LAS unsigned* st; };
__device__ __forceinline__ XcdBarrier xcd_barrier_post(unsigned* bar, volatile LAS unsigned* st) {
    XcdBarrier b; b.bar = bar; b.x = xb_xcc_id(); b.st = st;
    if (threadIdx.x == 0) (void)xb_add(&bar[XB_XCNT(b.x)], 1u);
    return b;
}
__device__ __forceinline__ void xcd_barrier_complete(unsigned* bar, unsigned x, unsigned& nloc, unsigned& nx) {
    const unsigned G = gridDim.x * gridDim.y * gridDim.z;
    unsigned sum, cnt, mine, sp = 0u;
    for (;;) {
        sum = 0u; cnt = 0u; mine = 0u;
#pragma unroll
        for (unsigned j = 0; j < 16; ++j) { const unsigned c = xb_ld(&bar[XB_XCNT(j)]); sum += c; cnt += (c > 0u) ? 1u : 0u; mine = (j == x) ? c : mine; }
        if (sum == G) break;
        __builtin_amdgcn_s_sleep(1);
        if ((++sp & 255u) == 0u) { if (xb_ld(&bar[XB_TMO])) break; if (sp > XB_SPIN_CAP) { atomicAdd(&bar[XB_TMO], 1u); break; } }
    }
    nloc = mine > 0u ? mine : 1u; nx = cnt > 0u ? cnt : 1u;
}
__device__ __forceinline__ void xcd_barrier(const XcdBarrier& b) {
    asm volatile("s_waitcnt vmcnt(0)" ::: "memory");
    __syncthreads();
    if (threadIdx.x == 0) {
        unsigned* bar = b.bar;
        __builtin_amdgcn_s_waitcnt(0);
        unsigned nloc = b.st[0], nx = b.st[1];
        if (nloc == 0u) { xcd_barrier_complete(bar, b.x, nloc, nx); b.st[0] = nloc; b.st[1] = nx; }
        const unsigned old = xb_add(&bar[XB_XSUB(b.x)], 1u);
        const unsigned gen = old / nloc;
        if (old + 1u == (gen + 1u) * nloc) {
            __builtin_amdgcn_fence(__ATOMIC_RELEASE, "agent");
            asm volatile("s_waitcnt vmcnt(0)" ::: "memory");
            const unsigned og = xb_add(&bar[XB_TOP], 1u);
            const unsigned tg = og / nx;
            if (og + 1u == (tg + 1u) * nx) xb_add(&bar[XB_TOPGEN], 1u);
            else XB_SPIN(xb_ld(&bar[XB_TOPGEN]) == tg, bar);
            __builtin_amdgcn_fence(__ATOMIC_ACQUIRE, "agent");
            xb_add(&bar[XB_XGEN(b.x)], 1u);
            asm volatile("s_waitcnt vmcnt(0)" ::: "memory");
        } else {
            XB_SPIN(xb_ld(&bar[XB_XGEN(b.x)]) == gen, bar);
            __builtin_amdgcn_fence(__ATOMIC_ACQUIRE, "agent");
            asm volatile("s_waitcnt vmcnt(0)" ::: "memory");
        }
    }
    __syncthreads();
}

namespace pg8 {
constexpr int BM = 256, BK = 64, HALF = 128, HTB = HALF * BK * 2, STAGE_BYTES = 8 * HTB, NXCD = 8, WGM = 8;
__host__ __device__ __forceinline__ int lds_byte(int r, int c) { const int st = (r >> 4) * 2 + (c >> 5), rr = r & 15, cc = c & 31, ob = rr * 64 + cc * 2; return st * 1024 + (ob ^ (((ob >> 9) & 1) << 5)); }
__host__ __device__ __forceinline__ void stage_rc(int b, int& R, int& C) { const int st = b / 1024, sb = b % 1024, swz = sb ^ (((sb >> 9) & 1) << 5); R = (st >> 1) * 16 + swz / 64; C = (st & 1) * 32 + (swz % 64) / 2; }
__host__ __device__ __forceinline__ int perm32(int rho) { const int n = rho >> 4, i = rho & 15; return 8 * (i >> 2) + 4 * n + (i & 3); }

struct Unit { const char* A; const char* B; unsigned ao00, ao01, ao10, ao11; int pm, pn, e, cnt, lr0; };

__device__ __forceinline__ unsigned cvt_pk_bf16(float lo, float hi) { unsigned r; asm volatile("v_cvt_pk_bf16_f32 %0, %1, %2" : "=v"(r) : "v"(lo), "v"(hi)); return r; }

struct DenseOrder {
    const char* A; const char* Bt; int K; int nM, nN, nwg, G, c; unsigned va0, va1;
    __device__ __forceinline__ void init(const void* A_, const void* Bt_, int M, int N, int K_, int G_, int c_) {
        A = (const char*)A_; Bt = (const char*)Bt_; K = K_; nM = M / BM; nN = N / BM; nwg = nM * nN; G = G_; c = c_;
        int R, C; stage_rc((int)threadIdx.x * 16, R, C); va0 = (unsigned)(R * K + C) * 2u; stage_rc((int)threadIdx.x * 16 + 8192, R, C); va1 = (unsigned)(R * K + C) * 2u;
    }
    __device__ __forceinline__ bool next(int i, Unit& u) const {
        const long L = (long)i * G + c; if (L >= nwg) return false;
        int wgid = (int)L; { const int q = nwg / NXCD, r = nwg % NXCD, xcd = wgid % NXCD, off = wgid / NXCD; wgid = (xcd < r ? xcd * (q + 1) : r * (q + 1) + (xcd - r) * q) + off; }
        const int nig = WGM * nN, gid = wgid / nig, fm = gid * WGM, gsz = (nM - fm) < WGM ? (nM - fm) : WGM;
        u.pm = fm + ((wgid % nig) % gsz); u.pn = (wgid % nig) / gsz; u.e = 0; u.cnt = 0; u.lr0 = 0;
        const size_t tstep = (size_t)BM * K * 2; const unsigned hstep = (unsigned)HALF * K * 2;
        u.A = A + (size_t)u.pm * tstep; u.B = Bt + (size_t)u.pn * tstep;
        u.ao00 = va0; u.ao01 = va1; u.ao10 = va0 + hstep; u.ao11 = va1 + hstep; return true;
    }
};

struct EpiBf16 {
    static constexpr bool PERM = true;
    bf16* O; int ldc; int qcols; float qscale;
    __device__ __forceinline__ void operator()(const f32x4 (&acc)[2][2][4][2], const Unit& u, int wr, int wc, int fr, int fq) const {
        const int row0 = u.pm * BM + wr * 64 + fr; const int colt = u.pn * BM;
        const float sc = (colt < qcols) ? qscale : 1.f;
        const int col0 = colt + wc * 32 + 8 * fq;
#pragma unroll
        for (int ai = 0; ai < 2; ++ai)
#pragma unroll
            for (int m = 0; m < 4; ++m) { bf16* rowp = O + (size_t)(row0 + ai * HALF + m * 16) * ldc + col0;
#pragma unroll
                for (int bj = 0; bj < 2; ++bj) { const f32x4 v0 = acc[ai][bj][m][0] * sc, v1 = acc[ai][bj][m][1] * sc;
                    v4u w; w.x = cvt_pk_bf16(v0[0], v0[1]); w.y = cvt_pk_bf16(v0[2], v0[3]); w.z = cvt_pk_bf16(v1[0], v1[1]); w.w = cvt_pk_bf16(v1[2], v1[3]);
                    *(v4u*)(rowp + bj * HALF) = w; } }
    }
};
struct EpiResid {
    static constexpr bool PERM = false;
    const float* x; const float* gate; float* out;
    __device__ __forceinline__ void operator()(const f32x4 (&acc)[2][2][4][2], const Unit& u, int wr, int wc, int fr, int fq) const {
        const int row0 = u.pm * BM + wr * 64 + fr, col0 = u.pn * BM + wc * 32 + 4 * fq;
        const int b = (u.pm * BM) / SEQ;
        f32x4 gv[2][2];
#pragma unroll
        for (int bj = 0; bj < 2; ++bj)
#pragma unroll
            for (int n = 0; n < 2; ++n) gv[bj][n] = *(const GAS f32x4*)(gate + b * 6144 + col0 + bj * HALF + n * 16);
#pragma unroll
        for (int ai = 0; ai < 2; ++ai)
#pragma unroll
            for (int mp = 0; mp < 2; ++mp) {
                f32x4 xv[2][2][2];
#pragma unroll
                for (int mm = 0; mm < 2; ++mm) { const size_t off = (size_t)(row0 + ai * HALF + (2 * mp + mm) * 16) * DM + col0;
#pragma unroll
                    for (int bj = 0; bj < 2; ++bj)
#pragma unroll
                        for (int n = 0; n < 2; ++n) xv[mm][bj][n] = *(const f32x4*)(x + off + bj * HALF + n * 16); }
                asm volatile("" ::: "memory");
#pragma unroll
                for (int mm = 0; mm < 2; ++mm) { const size_t off = (size_t)(row0 + ai * HALF + (2 * mp + mm) * 16) * DM + col0;
#pragma unroll
                    for (int bj = 0; bj < 2; ++bj)
#pragma unroll
                        for (int n = 0; n < 2; ++n) *(f32x4*)(out + off + bj * HALF + n * 16) = xv[mm][bj][n] + gv[bj][n] * acc[ai][bj][2 * mp + mm][n]; }
                asm volatile("" ::: "memory");
            }
    }
};
struct EpiSwiglu {
    static constexpr bool PERM = true;
    bf16* hid;
    __device__ __forceinline__ void operator()(const f32x4 (&acc)[2][2][4][2], const Unit& u, int wr, int wc, int fr, int fq) const {
        const int row0 = u.pm * BM + wr * 64 + fr; const int col0 = u.pn * HALF + wc * 32 + 8 * fq;
#pragma unroll
        for (int ai = 0; ai < 2; ++ai)
#pragma unroll
            for (int m = 0; m < 4; ++m) { bf16* rowp = hid + (size_t)(row0 + ai * HALF + m * 16) * DE + col0;
                float o[8];
#pragma unroll
                for (int n = 0; n < 2; ++n)
#pragma unroll
                    for (int j = 0; j < 4; ++j) { const float g = acc[ai][0][m][n][j], up = acc[ai][1][m][n][j];
                        o[n * 4 + j] = g * __builtin_amdgcn_rcpf(1.f + __builtin_amdgcn_exp2f(-g * LOG2E)) * up; }
                v4u w; w.x = cvt_pk_bf16(o[0], o[1]); w.y = cvt_pk_bf16(o[2], o[3]); w.z = cvt_pk_bf16(o[4], o[5]); w.w = cvt_pk_bf16(o[6], o[7]);
                *(v4u*)rowp = w; }
    }
};
struct EpiScatter {
    static constexpr bool PERM = true;
    bf16* Y; const int* list; const float* tokw;
    __device__ __forceinline__ void operator()(const f32x4 (&acc)[2][2][4][2], const Unit& u, int wr, int wc, int fr, int fq) const {
        const int col0 = u.pn * BM + wc * 32 + 8 * fq; const int* le = list + (size_t)u.e * T;
        int ts[2][4]; float w[2][4];
#pragma unroll
        for (int ai = 0; ai < 2; ++ai)
#pragma unroll
            for (int m = 0; m < 4; ++m) { const int lr = u.lr0 + ai * HALF + wr * 64 + m * 16 + fr; ts[ai][m] = (lr < u.cnt) ? le[lr] : -1; }
#pragma unroll
        for (int ai = 0; ai < 2; ++ai)
#pragma unroll
            for (int m = 0; m < 4; ++m) w[ai][m] = (ts[ai][m] >= 0) ? tokw[ts[ai][m]] : 0.f;
        asm volatile("" ::: "memory");
#pragma unroll
        for (int ai = 0; ai < 2; ++ai)
#pragma unroll
            for (int m = 0; m < 4; ++m) {
                if (ts[ai][m] >= 0) {
                    bf16* rowp = Y + ((size_t)(ts[ai][m] & 1) * T + (size_t)(ts[ai][m] >> 1)) * DM + col0; const float ww = w[ai][m];
#pragma unroll
                    for (int bj = 0; bj < 2; ++bj) { const f32x4 v0 = acc[ai][bj][m][0] * ww, v1 = acc[ai][bj][m][1] * ww;
                        v4u o; o.x = cvt_pk_bf16(v0[0], v0[1]); o.y = cvt_pk_bf16(v0[2], v0[3]); o.z = cvt_pk_bf16(v1[0], v1[1]); o.w = cvt_pk_bf16(v1[2], v1[3]);
                        *(v4u*)(rowp + bj * HALF) = o; } } }
    }
};

template <class Epi, class Sched, bool ALIGN_EPI>
__device__ __forceinline__ void gemm_phase(LAS unsigned char* lds, const int K, const Sched& S, const Epi& E) {
    const int tid = threadIdx.x, wid = __builtin_amdgcn_readfirstlane(tid >> 6), lane = tid & 63, wr = wid >> 2, wc = wid & 3, fr = lane & 15, fq = lane >> 4;
    const int nt = K / BK;
    unsigned voffB[2];
#pragma unroll
    for (int i = 0; i < 2; ++i) { int R, C; stage_rc(tid * 16 + i * 8192, R, C); const int Rb = Epi::PERM ? ((R & ~31) + perm32(R & 31)) : R; voffB[i] = (unsigned)(Rb * K + C) * 2u; }
    const size_t kstep = (size_t)(BK * 2);
    const size_t hstep = (size_t)HALF * K * 2;
    const unsigned ldsw = (unsigned)wid * 1024u;
    const int aoff = lds_byte(wr * 64 + fr, fq * 8), boff = lds_byte(wc * 32 + fr, fq * 8);
#define PG8_SA(b, h) (((b) * 2 + (h)) * HTB)
#define PG8_SB(b, h) ((4 + (b) * 2 + (h)) * HTB)
#define PG8_STAGE(bufoff, gbase, voff) do { _Pragma("unroll") for (int _i = 0; _i < 2; ++_i) \
        __builtin_amdgcn_global_load_lds((const unsigned*)((const char*)(gbase) + (voff)[_i]), (LAS unsigned*)(lds + (bufoff) + ldsw + _i * 8192), 16, 0, 0); } while (0)
#define PG8_STAGEA(bufoff, gbase, o0, o1) do { \
        __builtin_amdgcn_global_load_lds((const unsigned*)((const char*)(gbase) + (o0)), (LAS unsigned*)(lds + (bufoff) + ldsw), 16, 0, 0); \
        __builtin_amdgcn_global_load_lds((const unsigned*)((const char*)(gbase) + (o1)), (LAS unsigned*)(lds + (bufoff) + ldsw + 8192), 16, 0, 0); } while (0)
#define PG8_LDA(dst, b, h) do { _Pragma("unroll") for (int m = 0; m < 4; ++m) _Pragma("unroll") for (int k = 0; k < 2; ++k) dst[m][k] = *(const LAS bf16x8*)(lds + PG8_SA(b, h) + aoff + m * 2048 + k * 1024); } while (0)
#define PG8_LDB(dst, b, h) do { _Pragma("unroll") for (int n = 0; n < 2; ++n) _Pragma("unroll") for (int k = 0; k < 2; ++k) dst[n][k] = *(const LAS bf16x8*)(lds + PG8_SB(b, h) + boff + n * 2048 + k * 1024); } while (0)
#define PG8_MMA(ai, bj, At, Bt) do { __builtin_amdgcn_s_setprio(1); _Pragma("unroll") for (int m = 0; m < 4; ++m) _Pragma("unroll") for (int n = 0; n < 2; ++n) _Pragma("unroll") for (int k = 0; k < 2; ++k) \
        acc[ai][bj][m][n] = __builtin_amdgcn_mfma_f32_16x16x32_bf16(Bt[n][k], At[m][k], acc[ai][bj][m][n], 0, 0, 0); __builtin_amdgcn_s_setprio(0); } while (0)
#define PG8_WAIT_V(n) asm volatile("s_waitcnt vmcnt(" #n ")" ::: "memory")
#define PG8_WAIT_L(n) asm volatile("s_waitcnt lgkmcnt(" #n ")" ::: "memory")
#define PG8_BAR __builtin_amdgcn_s_barrier()
#define PG8_SCHED __builtin_amdgcn_sched_barrier(0)
    Unit cur, nxt; int ui = 0;
    if (!S.next(0, cur)) return;
    f32x4 acc[2][2][4][2];
#pragma unroll
    for (int a = 0; a < 2; ++a)
#pragma unroll
        for (int b = 0; b < 2; ++b)
#pragma unroll
            for (int m = 0; m < 4; ++m)
#pragma unroll
                for (int n = 0; n < 2; ++n) acc[a][b][m][n] = (f32x4){0.f, 0.f, 0.f, 0.f};
    bf16x8 At[4][2], B0[2][2], B1[2][2];
    const char* cA = cur.A; const char* cB = cur.B;
    unsigned c00 = cur.ao00, c01 = cur.ao01, c10 = cur.ao10, c11 = cur.ao11;
    PG8_STAGE(PG8_SB(0, 0), cB, voffB); PG8_STAGE(PG8_SB(0, 1), cB + hstep, voffB); PG8_STAGEA(PG8_SA(0, 0), cA, c00, c01); PG8_STAGEA(PG8_SA(0, 1), cA, c10, c11);
    if (wr == 1) PG8_BAR;
    PG8_WAIT_V(2); PG8_BAR;
    PG8_STAGE(PG8_SB(1, 0), cB + kstep, voffB); PG8_STAGEA(PG8_SA(1, 0), cA + kstep, c00, c01); PG8_STAGE(PG8_SB(1, 1), cB + hstep + kstep, voffB);
    PG8_WAIT_V(6); PG8_BAR;
    for (;;) {
        const bool has_next = S.next(ui + 1, nxt);
        const char* nA = has_next ? nxt.A : cA; const char* nB = has_next ? nxt.B : cB;
        const unsigned n00 = has_next ? nxt.ao00 : c00, n01 = has_next ? nxt.ao01 : c01, n10 = has_next ? nxt.ao10 : c10, n11 = has_next ? nxt.ao11 : c11;
        for (int t = 0; t < nt; t += 2) {
            const bool last = (t == nt - 2);
            const char* a1 = cA + (size_t)(t + 1) * kstep;
            const char* a2 = last ? nA : cA + (size_t)(t + 2) * kstep; const char* b2 = last ? nB : cB + (size_t)(t + 2) * kstep;
            const char* a3 = a2 + kstep; const char* b3 = b2 + kstep;
            const unsigned o00 = last ? n00 : c00, o01 = last ? n01 : c01, o10 = last ? n10 : c10, o11 = last ? n11 : c11;
            PG8_LDB(B0, 0, 0); PG8_LDB(B1, 0, 1); PG8_SCHED; PG8_LDA(At, 0, 0); PG8_STAGEA(PG8_SA(1, 1), a1, c10, c11);
            PG8_WAIT_V(8); PG8_WAIT_L(0); PG8_BAR; PG8_MMA(0, 0, At, B0); PG8_MMA(0, 1, At, B1); PG8_BAR; PG8_SCHED;
            PG8_LDA(At, 0, 1); PG8_STAGE(PG8_SB(0, 0), b2, voffB); PG8_STAGE(PG8_SB(0, 1), b2 + hstep, voffB); PG8_STAGEA(PG8_SA(0, 0), a2, o00, o01);
            PG8_WAIT_V(8); PG8_WAIT_L(0); PG8_BAR; PG8_MMA(1, 0, At, B0); PG8_MMA(1, 1, At, B1); PG8_BAR; PG8_SCHED;
            PG8_LDB(B0, 1, 0); PG8_LDB(B1, 1, 1); PG8_SCHED; PG8_LDA(At, 1, 0); PG8_STAGEA(PG8_SA(0, 1), a2, o10, o11);
            PG8_WAIT_V(8); PG8_WAIT_L(0); PG8_BAR; PG8_MMA(0, 0, At, B0); PG8_MMA(0, 1, At, B1); PG8_BAR; PG8_SCHED;
            PG8_LDA(At, 1, 1); PG8_STAGE(PG8_SB(1, 0), b3, voffB); PG8_STAGE(PG8_SB(1, 1), b3 + hstep, voffB); PG8_STAGEA(PG8_SA(1, 0), a3, o00, o01);
            PG8_WAIT_V(8); PG8_WAIT_L(0); PG8_BAR; PG8_MMA(1, 0, At, B0); PG8_MMA(1, 1, At, B1); PG8_BAR; PG8_SCHED;
        }
        if constexpr (ALIGN_EPI) { if (wr == 0) PG8_BAR; }
        E(acc, cur, wr, wc, fr, fq);
        if (!has_next) break;
#pragma unroll
        for (int a = 0; a < 2; ++a)
#pragma unroll
            for (int b = 0; b < 2; ++b)
#pragma unroll
                for (int m = 0; m < 4; ++m)
#pragma unroll
                    for (int n = 0; n < 2; ++n) acc[a][b][m][n] = (f32x4){0.f, 0.f, 0.f, 0.f};
        cur = nxt; cA = nA; cB = nB; c00 = n00; c01 = n01; c10 = n10; c11 = n11; ++ui;
        if constexpr (ALIGN_EPI) { if (wr == 1) PG8_BAR; }
    }
    PG8_WAIT_V(0);
    if constexpr (!ALIGN_EPI) { if (wr == 0) PG8_BAR; }
    PG8_BAR;
#undef PG8_SA
#undef PG8_SB
#undef PG8_STAGE
#undef PG8_STAGEA
#undef PG8_LDA
#undef PG8_LDB
#undef PG8_MMA
#undef PG8_WAIT_V
#undef PG8_WAIT_L
#undef PG8_BAR
#undef PG8_SCHED
}
}

template <int WHICH>
struct MoeOrder {
    const LAS int* tab; int G, c, NU; const char* Abase; const char* Bbase; const int* list; unsigned va0, va1; int R0, R1, C0, C1;
    __device__ __forceinline__ void init(const LAS int* tab_, int G_, int c_, const void* A_, const void* B_, const int* list_) {
        tab = tab_; G = G_; c = c_; NU = 4 * tab_[16]; Abase = (const char*)A_; Bbase = (const char*)B_; list = list_;
        pg8::stage_rc((int)threadIdx.x * 16, R0, C0); pg8::stage_rc((int)threadIdx.x * 16 + 8192, R1, C1);
        constexpr int K = (WHICH == 1) ? DM : DE;
        va0 = (unsigned)(R0 * K + C0) * 2u; va1 = (unsigned)(R1 * K + C1) * 2u;
    }
    __device__ __forceinline__ bool next(int i, pg8::Unit& u) const {
        const int uidx = i * G + c; if (uidx >= NU) return false;
        const int rtg = uidx >> 2, pn = uidx & 3;
        int e = 0;
#pragma unroll
        for (int k = 1; k < 16; ++k) e = (rtg >= tab[k]) ? k : e;
        const int rt = rtg - tab[e]; const int ce = tab[17 + e];
        u.pm = rtg; u.pn = pn; u.e = e; u.cnt = ce; u.lr0 = rt * 256;
        if (WHICH == 1) {
            const int* le = list + (size_t)e * T + rt * 256;
            const int r00 = rt * 256 + R0, r01 = rt * 256 + R1, r10 = r00 + 128, r11 = r01 + 128;
            const int t00 = (r00 < ce) ? (le[R0] >> 1) : 0, t01 = (r01 < ce) ? (le[R1] >> 1) : 0, t10 = (r10 < ce) ? (le[128 + R0] >> 1) : 0, t11 = (r11 < ce) ? (le[128 + R1] >> 1) : 0;
            u.A = Abase;
            u.ao00 = (unsigned)(t00 * DM + C0) * 2u; u.ao01 = (unsigned)(t01 * DM + C1) * 2u; u.ao10 = (unsigned)(t10 * DM + C0) * 2u; u.ao11 = (unsigned)(t11 * DM + C1) * 2u;
            u.B = Bbase + (size_t)e * (DM * DM * 2) + (size_t)pn * (256 * DM * 2);
        } else {
            u.A = Abase + (size_t)rtg * (256 * DE * 2);
            u.ao00 = va0; u.ao01 = va1; u.ao10 = va0 + 128 * DE * 2; u.ao11 = va1 + 128 * DE * 2;
            u.B = Bbase + (size_t)e * (DM * DE * 2) + (size_t)pn * (256 * DE * 2);
        }
        return true;
    }
};

namespace att {
constexpr int PITCH = NPROJ;
constexpr int KSLOT = 16384, VSLOT = 16384;
constexpr int L_K = 0, L_V = 3 * KSLOT, L_WS = L_V + 3 * VSLOT, L_DT = L_WS + 8 * 256, L_END = L_DT + 2 * 512;
constexpr int L_STASH = 0, L_STAGE = 65536;
constexpr float THR = 8.f;
typedef LAS const char* lds_cptr;
typedef short v4i16_t __attribute__((ext_vector_type(4)));
__device__ __forceinline__ int crow(int r, int hi) { return (r & 3) + 8 * (r >> 2) + 4 * hi; }
__device__ __forceinline__ void glds16(const void* gsrc, unsigned lds_dst) { unsigned keep;
    asm volatile("s_mov_b32 %0, m0\n\ts_mov_b32 m0, %2\n\ts_nop 0\n\tglobal_load_lds_dwordx4 %1, off\n\ts_mov_b32 m0, %0" : "=&s"(keep) : "v"(gsrc), "s"(lds_dst) : "memory"); }
__device__ __forceinline__ unsigned cvtpk(float lo, float hi) { typedef __bf16 bf16x2_t __attribute__((ext_vector_type(2))); f32x2 v = {lo, hi}; bf16x2_t b = __builtin_convertvector(v, bf16x2_t); return __builtin_bit_cast(unsigned, b); }
__device__ __forceinline__ s16x4 vtr(lds_cptr p) { return __builtin_bit_cast(s16x4, __builtin_amdgcn_ds_read_tr16_b64_v4i16((LAS v4i16_t*)p)); }
#define MX3(a, b, c) __builtin_fmaxf(__builtin_fmaxf((a), (b)), (c))
__device__ __forceinline__ float rowmax(const f32x16& p0, const f32x16& p1) {
    float a = MX3(p0[0], p0[1], p1[0]), b = MX3(p0[2], p0[3], p1[1]); a = MX3(a, p1[2], p1[3]);
#pragma unroll
    for (int r = 4; r < 16; r += 4) { a = MX3(a, p0[r], p0[r + 1]); b = MX3(b, p0[r + 2], p0[r + 3]); a = MX3(a, p1[r], p1[r + 1]); b = MX3(b, p1[r + 2], p1[r + 3]); }
    float m = __builtin_fmaxf(a, b); auto rr = __builtin_amdgcn_permlane32_swap(__float_as_uint(m), __float_as_uint(m), false, false);
    return __builtin_fmaxf(__uint_as_float(rr[0]), __uint_as_float(rr[1])); }
#undef MX3
#define ATT_WAIT_BAR(N) asm volatile("s_waitcnt vmcnt(" #N ") lgkmcnt(0)\n\ts_barrier" ::: "memory")

__device__ __forceinline__ void unit(const int b, const int h, const int j, const bf16* proj, const int* pos, const bool nonaff, const float* dtab, const float* bfar,
                                     const float lam, const float* subln_g, bf16* outp, char* shm) {
    const int tid = threadIdx.x, lane = tid & 63, r32 = lane & 31, hi = lane >> 5; const int wid = __builtin_amdgcn_readfirstlane(tid >> 6);
    const int m = wid >> 2, rg = wid & 3, comp = 2 * h + m;
    const long rowbase = (long)b * SEQ; const int q0 = j * 128, NT = 2 * j + 2;
    const unsigned lds0 = (unsigned)(uintptr_t)shm;
    float* wsf = (float*)(shm + L_WS) + wid * 64;
    float* dtl = (float*)(shm + L_DT) + m * 128;
    if (tid < 256) ((float*)(shm + L_DT))[tid] = dtab[(2 * h + (tid >> 7)) * 128 + (tid & 127)];
    const float bf = ld_f32_agent(bfar + comp);
    const bf16* Qw = proj + (rowbase + q0 + rg * 32) * PITCH + comp * 64;
    bf16x8 qr[4];
#pragma unroll
    for (int d0 = 0; d0 < 4; ++d0) qr[d0] = *reinterpret_cast<const bf16x8*>(&Qw[(long)r32 * PITCH + d0 * 16 + hi * 8]);
    const int qidx = q0 + rg * 32 + r32;
    const int pq = pos[rowbase + qidx];
    const bf16* k0src = proj + rowbase * PITCH + 512 + (2 * h) * 64 + (long)lane * PITCH + wid * 8;
    const bf16* k1src = k0src + 64;
    const bf16* v0src = proj + rowbase * PITCH + 1024 + h * 128 + (long)(16 * (wid & 3) + (lane >> 2)) * PITCH + (wid >> 2) * 32 + (lane & 3) * 8;
    const bf16* v1src = v0src + 64;
    const unsigned kdst = lds0 + L_K + wid * 1024, vdst = lds0 + L_V + wid * 1024;
#define ATT_DMA(t, slot) do { const long _o = (long)(t) * 64 * PITCH; \
        glds16(k0src + _o, (unsigned)__builtin_amdgcn_readfirstlane(kdst + (slot) * KSLOT)); glds16(k1src + _o, (unsigned)__builtin_amdgcn_readfirstlane(kdst + (slot) * KSLOT + 8192)); \
        glds16(v0src + _o, (unsigned)__builtin_amdgcn_readfirstlane(vdst + (slot) * VSLOT)); glds16(v1src + _o, (unsigned)__builtin_amdgcn_readfirstlane(vdst + (slot) * VSLOT + 8192)); } while (0)
    ATT_DMA(0, 0); ATT_DMA(1, 1);
    const lds_cptr shm3 = (lds_cptr)shm;
    const lds_cptr kp0 = shm3 + L_K + m * 8192 + hi * 1024 + r32 * 16;
    const lds_cptr vp0 = shm3 + L_V + ((lane >> 4) & 1) * 32 + (lane & 3) * 8 + (4 * hi + ((lane & 15) >> 2)) * 64;
    float mhat = 0.f, l_reg = 0.f;
    f32x16 o[4]; o[0] = f32x16{}; o[1] = f32x16{}; o[2] = f32x16{}; o[3] = f32x16{};
    f32x16 negm;
#pragma unroll
    for (int r = 0; r < 16; ++r) negm[r] = bf;
    int slot = 0;
    for (int t = 0; t < NT; ++t) {
        if (t + 1 < NT) { ATT_WAIT_BAR(4); } else { ATT_WAIT_BAR(0); }
        if (t + 2 < NT) { const int s2 = (slot == 0) ? 2 : slot - 1; ATT_DMA(t + 2, s2); }
        const lds_cptr kp = kp0 + slot * KSLOT;
        f32x16 p0, p1;
#pragma unroll
        for (int d0 = 0; d0 < 4; ++d0) {
            const bf16x8 b0 = *(const LAS bf16x8*)(kp + d0 * 2048);
            const bf16x8 b1 = *(const LAS bf16x8*)(kp + d0 * 2048 + 512);
            if (d0 == 0) { p0 = __builtin_amdgcn_mfma_f32_32x32x16_bf16(b0, qr[0], negm, 0, 0, 0); p1 = __builtin_amdgcn_mfma_f32_32x32x16_bf16(b1, qr[0], negm, 0, 0, 0); }
            else { p0 = __builtin_amdgcn_mfma_f32_32x32x16_bf16(b0, qr[d0], p0, 0, 0, 0); p1 = __builtin_amdgcn_mfma_f32_32x32x16_bf16(b1, qr[d0], p1, 0, 0, 0); }
        }
        if (nonaff || t >= NT - 4) {
            const int kb = 64 * t + 4 * hi;
#pragma unroll
            for (int r = 0; r < 16; ++r) {
                const int kv0 = kb + (r & 3) + 8 * (r >> 2), kv1 = kv0 + 32;
                int d0_, d1_;
                if (nonaff) { d0_ = pq - pos[rowbase + kv0]; d1_ = pq - pos[rowbase + kv1]; } else { d0_ = qidx - kv0; d1_ = qidx - kv1; }
                d0_ = d0_ < 0 ? 0 : (d0_ > 127 ? 127 : d0_); d1_ = d1_ < 0 ? 0 : (d1_ > 127 ? 127 : d1_);
                p0[r] = (kv0 > qidx) ? -INFINITY : p0[r] + dtl[d0_];
                p1[r] = (kv1 > qidx) ? -INFINITY : p1[r] + dtl[d1_];
            }
        }
        const float rm = rowmax(p0, p1);
        if (t == 0 || __any(rm > THR)) {
            const float dl = (t == 0) ? rm : __builtin_fmaxf(rm, 0.f);
            mhat += dl;
#pragma unroll
            for (int r = 0; r < 16; ++r) { p0[r] -= dl; p1[r] -= dl; negm[r] = bf - mhat; }
            if (t != 0) {
                const float f = __builtin_amdgcn_exp2f(-dl); l_reg *= f;
                if (hi == 0) wsf[r32] = f;
                LDS_WAIT();
#pragma unroll
                for (int r = 0; r < 16; ++r) { const float fr_ = wsf[crow(r, hi)];
#pragma unroll
                    for (int dq = 0; dq < 4; ++dq) o[dq][r] *= fr_; }
            }
        }
        float sacc = 0.f;
#pragma unroll
        for (int r = 0; r < 16; ++r) { p0[r] = __builtin_amdgcn_exp2f(p0[r]); p1[r] = __builtin_amdgcn_exp2f(p1[r]); sacc += p0[r] + p1[r]; }
        l_reg += sacc;
        v4u pw[4];
#pragma unroll
        for (int q4 = 0; q4 < 4; ++q4) { pw[0][q4] = cvtpk(p0[2 * q4], p0[2 * q4 + 1]); pw[1][q4] = cvtpk(p0[8 + 2 * q4], p0[8 + 2 * q4 + 1]);
                                         pw[2][q4] = cvtpk(p1[2 * q4], p1[2 * q4 + 1]); pw[3][q4] = cvtpk(p1[8 + 2 * q4], p1[8 + 2 * q4 + 1]); }
        const lds_cptr vp = vp0 + slot * VSLOT;
#pragma unroll
        for (int dq = 0; dq < 4; ++dq)
#pragma unroll
            for (int ks = 0; ks < 4; ++ks) {
                const s16x4 lo = vtr(vp + dq * 4096 + ks * 1024), hi_ = vtr(vp + dq * 4096 + ks * 1024 + 512);
                const bf16x8 vf = (bf16x8){lo[0], lo[1], lo[2], lo[3], hi_[0], hi_[1], hi_[2], hi_[3]};
                o[dq] = __builtin_amdgcn_mfma_f32_32x32x16_bf16(__builtin_bit_cast(bf16x8, pw[ks]), vf, o[dq], 0, 0, 0);
            }
        slot = (slot == 2) ? 0 : slot + 1;
    }
    { auto rr = __builtin_amdgcn_permlane32_swap(__float_as_uint(l_reg), __float_as_uint(l_reg), false, false); l_reg = __uint_as_float(rr[0]) + __uint_as_float(rr[1]); }
    if (hi == 0) wsf[32 + r32] = l_reg;
    LDS_WAIT();
    float rli[16];
#pragma unroll
    for (int r = 0; r < 16; ++r) rli[r] = __builtin_amdgcn_rcpf(wsf[32 + crow(r, hi)]);
    asm volatile("s_waitcnt lgkmcnt(0)\n\ts_barrier" ::: "memory");
    float* stash = (float*)(shm + L_STASH) + rg * 4096;
    if (m == 1) {
#pragma unroll
        for (int r = 0; r < 16; ++r)
#pragma unroll
            for (int dq = 0; dq < 4; ++dq) stash[crow(r, hi) * 128 + dq * 32 + r32] = lam * o[dq][r] * rli[r];
    }
    asm volatile("s_waitcnt lgkmcnt(0)\n\ts_barrier" ::: "memory");
    if (m == 0) {
        float ss[16];
#pragma unroll
        for (int r = 0; r < 16; ++r) { float s = 0.f;
#pragma unroll
            for (int dq = 0; dq < 4; ++dq) { const float dv = o[dq][r] * rli[r] - stash[crow(r, hi) * 128 + dq * 32 + r32]; o[dq][r] = dv; s += dv * dv; }
            ss[r] = s; }
#pragma unroll
        for (int r = 0; r < 16; ++r) {
#pragma unroll
            for (int of = 1; of < 32; of <<= 1) ss[r] += __shfl_xor(ss[r], of);
            ss[r] = __builtin_amdgcn_rsqf(ss[r] * (1.f / 128.f) + 1e-5f) * 0.8f;
        }
        bf16* stg = (bf16*)(shm + L_STAGE) + rg * 4096;
        float gcol[4];
#pragma unroll
        for (int dq = 0; dq < 4; ++dq) gcol[dq] = subln_g[dq * 32 + r32];
#pragma unroll
        for (int r = 0; r < 16; ++r)
#pragma unroll
            for (int dq = 0; dq < 4; ++dq) stg[crow(r, hi) * 128 + dq * 32 + r32] = (bf16)f2bf(o[dq][r] * ss[r] * gcol[dq]);
        LDS_WAIT();
        bf16* Ow = outp + (rowbase + q0 + rg * 32) * DM + h * 128;
#pragma unroll
        for (int i = 0; i < 8; ++i) { const int row = i * 4 + (lane >> 4), ch = lane & 15; const v4u v = *(const v4u*)(stg + row * 128 + ch * 8); *(v4u*)(Ow + (long)row * DM + ch * 8) = v; }
    }
    asm volatile("s_waitcnt lgkmcnt(0)\n\ts_barrier" ::: "memory");
#undef ATT_DMA
}
#undef ATT_WAIT_BAR
}

__device__ __forceinline__ int fresh_lane() { int l; asm volatile("v_mbcnt_lo_u32_b32 %0, -1, 0\n\tv_mbcnt_hi_u32_b32 %0, -1, %0" : "=v"(l)); return l; }
__device__ __forceinline__ float wave_sum(float v) {
#pragma unroll
    for (int o = 1; o < 64; o <<= 1) v += __shfl_xor(v, o);
    return v;
}
__device__ __forceinline__ void transpose_item(const float* W, int ldw, int k0, int n0, bf16* WT, int ldt, int drow0, LAS float* scr, int lane) {
#pragma unroll 8
    for (int i = 0; i < 32; ++i) { const int kk = 2 * i + (lane >> 5); scr[kk * 33 + (lane & 31)] = W[(size_t)(k0 + kk) * ldw + n0 + (lane & 31)]; }
    LDS_WAIT(); asm volatile("" ::: "memory");
    const int c = lane & 7;
#pragma unroll
    for (int j = 0; j < 4; ++j) { const int n = (lane >> 3) + 8 * j; const LAS float* s = scr + (8 * c) * 33 + n;
        v4u o; o.x = pk2(s[0 * 33], s[1 * 33]); o.y = pk2(s[2 * 33], s[3 * 33]); o.z = pk2(s[4 * 33], s[5 * 33]); o.w = pk2(s[6 * 33], s[7 * 33]);
        *(GAS v4u*)(WT + (size_t)(drow0 + n) * ldt + k0 + 8 * c) = o; }
    LDS_WAIT(); asm volatile("" ::: "memory");
}
__device__ __forceinline__ int rel_bucket(int n) {
    n = n < 0 ? 0 : n;
    if (n < 16) return n;
    int large = 16 + (int)(logf((float)n / 16.f) / 2.0794415416798357f * 16.f);
    return large < 31 ? large : 31;
}

struct Args { const void* in[24]; float* out; unsigned char* ws; };

__global__ void __launch_bounds__(512, 2) mk_fwd(Args args) {
    extern __shared__ __attribute__((aligned(16))) unsigned char lds[];
    LAS unsigned char* L = (LAS unsigned char*)lds;
    volatile LAS unsigned* MISC = (volatile LAS unsigned*)(L + MISC_OFF);
    const int tid = threadIdx.x, lane = tid & 63, wave = __builtin_amdgcn_readfirstlane(tid >> 6);
    const int G = gridDim.x, bx = blockIdx.x;
    const int vcu = (G % 8 == 0) ? (bx % 8) * (G / 8) + bx / 8 : bx;
    unsigned char* ws = args.ws;
    unsigned* ctl = (unsigned*)(ws + WS_CTL);
    const float* x = (const float*)args.in[0]; const float* cvec = (const float*)args.in[1]; const int* pos = (const int*)args.in[2];
    const float* rel_bias = (const float*)args.in[3]; const float* ada_w = (const float*)args.in[4]; const float* ada_b = (const float*)args.in[5];
    const float* norm1_g = (const float*)args.in[6]; const float* w_in = (const float*)args.in[7];
    const float* lq1 = (const float*)args.in[8]; const float* lk1 = (const float*)args.in[9]; const float* lq2 = (const float*)args.in[10]; const float* lk2 = (const float*)args.in[11];
    const float* subln_g = (const float*)args.in[12]; const float* conv_w = (const float*)args.in[13]; const float* w_out = (const float*)args.in[14];
    const float* norm2_g = (const float*)args.in[15]; const float* rgw = (const float*)args.in[16]; const float* rgb = (const float*)args.in[17];
    const float* rew = (const float*)args.in[18]; const float* reb = (const float*)args.in[19];
    const float* wg = (const float*)args.in[20]; const float* wu = (const float*)args.in[21]; const float* wd = (const float*)args.in[22]; const float* fing = (const float*)args.in[23];
    float* out = args.out;
    bf16* WIN = (bf16*)(ws + WS_WIN); bf16* WOUT = (bf16*)(ws + WS_WOUT); bf16* WGU = (bf16*)(ws + WS_WGU); bf16* WD = (bf16*)(ws + WS_WD);
    float* ADA = (float*)(ws + WS_SMALL); float* LAM = (float*)(ws + WS_SMALL + 65536); float* DTAB = (float*)(ws + WS_SMALL + 68 * 1024); float* BFAR = (float*)(ws + WS_SMALL + 72 * 1024);
    int* LIST = (int*)(ws + WS_LIST); float* TOKW = (float*)(ws + WS_TOKW);
    bf16* ACT = (bf16*)(ws + WS_ACT); bf16* PROJ = (bf16*)(ws + WS_PROJ); bf16* HID = (bf16*)(ws + WS_PROJ); bf16* Y = (bf16*)(ws + WS_Y);

    for (int u = tid; u < (LDS_BYTES - LDSCTL_OFF) / 4; u += 512) ((LAS unsigned*)(L + LDSCTL_OFF))[u] = 0u;
    __syncthreads();
    XcdBarrier bar = xcd_barrier_post(ctl + CW_BAR, MISC + 8);
    const int gw = vcu * 8 + wave, NGW = G * 8;

    {
        if (bx < 192) {
            LAS float* sc = (LAS float*)L;
            LAS float* red = (LAS float*)(L + 8192);
            for (int i = tid; i < 2048; i += 512) { const float v = cvec[i]; sc[i] = v / (1.f + __expf(-v)); }
            __syncthreads();
            const int kk = tid >> 5, jj = tid & 31, jcol = bx * 32 + jj;
            float a0 = 0.f, a1 = 0.f;
#pragma unroll 8
            for (int k = kk; k < 1024; k += 16) { const float wv = ada_w[(size_t)k * 6144 + jcol]; a0 += sc[k] * wv; a1 += sc[1024 + k] * wv; }
            red[(kk * 32 + jj) * 2] = a0; red[(kk * 32 + jj) * 2 + 1] = a1;
            __syncthreads();
            if (tid < 64) { const int j2 = tid & 31, b2 = tid >> 5; float s = 0.f;
#pragma unroll
                for (int q = 0; q < 16; ++q) s += red[(q * 32 + j2) * 2 + b2];
                ADA[b2 * 6144 + bx * 32 + j2] = s + ada_b[bx * 32 + j2]; }
            __syncthreads();
        } else if (bx == 192) {
            if (tid == 0) { float s1 = 0.f, s2 = 0.f; for (int i = 0; i < 64; ++i) { s1 += lq1[i] * lk1[i]; s2 += lq2[i] * lk2[i]; } LAM[0] = expf(s1) - expf(s2) + 0.2f; }
            for (int i = tid; i < 1024; i += 512) { const int c = i >> 7, d = i & 127; DTAB[i] = (rel_bias[rel_bucket(d) * 8 + c] - rel_bias[31 * 8 + c]) * LOG2E; }
            if (tid < 8) BFAR[tid] = rel_bias[31 * 8 + tid] * LOG2E;
        } else if (bx == 193) {
            for (int i = tid; i < BATCH * (SEQ - 1); i += 512) { const int b = i / (SEQ - 1), s = i % (SEQ - 1);
                if (pos[b * SEQ + s + 1] - pos[b * SEQ + s] != 1) atomicOr(&ctl[CW_NONAFF + 64 * b], 1u); }
        }
        LAS float* scr = (LAS float*)(L + wave * 16384);
        constexpr int I_IN = 16 * 96, I_OUT = 16 * 32, I_G = 16 * 16, I_D = 8 * 32, I_E = 2 * I_G + I_D;
        constexpr int NITEMS = I_IN + I_OUT + NE * I_E;
        for (int it = gw; it < NITEMS; it += NGW) {
            int r = it;
            if (r < I_IN) { const int kb = r / 96, nb = r % 96; transpose_item(w_in, NPROJ, kb * 64, nb * 32, WIN, DM, nb * 32, scr, lane); continue; } r -= I_IN;
            if (r < I_OUT) { const int kb = r / 32, nb = r % 32; transpose_item(w_out, DM, kb * 64, nb * 32, WOUT, DM, nb * 32, scr, lane); continue; } r -= I_OUT;
            const int e = r / I_E; r -= e * I_E;
            if (r < 2 * I_G) { const int up = r / I_G; r -= up * I_G; const int kb = r / 16, nb = r % 16, n0 = nb * 32;
                transpose_item((up ? wu : wg) + (size_t)e * DM * DE, DE, kb * 64, n0, WGU + (size_t)e * DM * DM, DM, (n0 >> 7) * 256 + (n0 & 127) + up * 128, scr, lane); continue; }
            r -= 2 * I_G; { const int kb = r / 32, nb = r % 32; transpose_item(wd + (size_t)e * DE * DM, DM, kb * 64, nb * 32, WD + (size_t)e * DM * DE, DE, nb * 32, scr, lane); }
        }
    }
    xcd_barrier(bar);

    for (int row = gw; row < T; row += NGW) {
        const int lane = fresh_lane();
        const int b = row / SEQ; const float* ad = ADA + b * 6144;
        const GAS f32x4* xr = (const GAS f32x4*)(x + (size_t)row * DM) + lane;
        f32x4 v[4]; float s = 0.f;
#pragma unroll
        for (int jj = 0; jj < 4; ++jj) { v[jj] = xr[64 * jj]; s += (v[jj].x * v[jj].x + v[jj].y * v[jj].y) + (v[jj].z * v[jj].z + v[jj].w * v[jj].w); }
        const float rstd = rsqrtf(wave_sum(s) * (1.f / DM) + 1e-6f);
        GAS unsigned long long* o8 = (GAS unsigned long long*)(ACT + (size_t)row * DM) + lane;
#pragma unroll
        for (int jj = 0; jj < 4; ++jj) { const int k = 4 * lane + 256 * jj;
            const f32x4 g = *(const f32x4*)(norm1_g + k), sh = *(const GAS f32x4*)(ad + k), sc = *(const GAS f32x4*)(ad + 1024 + k);
            const f32x4 y = v[jj] * rstd * g * (sc + 1.f) + sh;
            o8[64 * jj] = (unsigned long long)pk2(y.x, y.y) | ((unsigned long long)pk2(y.z, y.w) << 32); }
    }
    xcd_barrier(bar);

    {
        pg8::DenseOrder S; S.init(ACT, WIN, T, NPROJ, DM, G, bx);
        pg8::EpiBf16 E{PROJ, NPROJ, 512, C2};
        pg8::gemm_phase<pg8::EpiBf16, pg8::DenseOrder, true>(L, DM, S, E);
    }
    xcd_barrier(bar);

    {
        for (int it = (vcu * 512 + tid); it < T * 64; it += G * 512) {
            const int tk = it >> 6, c8 = (it & 63) * 8, s = tk % SEQ;
            const bf16* pr = PROJ + (size_t)tk * NPROJ;
            const v4u gb = *(const v4u*)(pr + 1536 + c8), gc0 = *(const v4u*)(pr + 2048 + c8), hc0 = *(const v4u*)(pr + 2560 + c8);
            v4u gc1 = (v4u){0, 0, 0, 0}, hc1 = gc1, gc2 = gc1, hc2 = gc1;
            if (s >= 1) { gc1 = *(const v4u*)(pr - NPROJ + 2048 + c8); hc1 = *(const v4u*)(pr - NPROJ + 2560 + c8); }
            if (s >= 2) { gc2 = *(const v4u*)(pr - 2 * NPROJ + 2048 + c8); hc2 = *(const v4u*)(pr - 2 * NPROJ + 2560 + c8); }
            const f32x4 w0a = *(const f32x4*)(conv_w + c8), w0b = *(const f32x4*)(conv_w + c8 + 4), w1a = *(const f32x4*)(conv_w + 512 + c8), w1b = *(const f32x4*)(conv_w + 512 + c8 + 4),
                        w2a = *(const f32x4*)(conv_w + 1024 + c8), w2b = *(const f32x4*)(conv_w + 1024 + c8 + 4);
            const float w0[8] = {w0a.x, w0a.y, w0a.z, w0a.w, w0b.x, w0b.y, w0b.z, w0b.w}, w1[8] = {w1a.x, w1a.y, w1a.z, w1a.w, w1b.x, w1b.y, w1b.z, w1b.w}, w2[8] = {w2a.x, w2a.y, w2a.z, w2a.w, w2b.x, w2b.y, w2b.z, w2b.w};
            v4u o;
#pragma unroll
            for (int q = 0; q < 4; ++q) {
                const float u0l = bf_lo(gc0[q]) * bf_lo(hc0[q]), u0h = bf_hi(gc0[q]) * bf_hi(hc0[q]);
                const float u1l = bf_lo(gc1[q]) * bf_lo(hc1[q]), u1h = bf_hi(gc1[q]) * bf_hi(hc1[q]);
                const float u2l = bf_lo(gc2[q]) * bf_lo(hc2[q]), u2h = bf_hi(gc2[q]) * bf_hi(hc2[q]);
                const float yl = bf_lo(gb[q]) * (w0[2 * q] * u2l + w1[2 * q] * u1l + w2[2 * q] * u0l);
                const float yh = bf_hi(gb[q]) * (w0[2 * q + 1] * u2h + w1[2 * q + 1] * u1h + w2[2 * q + 1] * u0h);
                o[q] = pk2(yl, yh);
            }
            *(v4u*)(ACT + (size_t)tk * DM + 512 + c8) = o;
        }
        VM_WAIT(); __syncthreads();
        const int bh = vcu >> 5, jj = vcu & 31, b = bh >> 2, h = bh & 3;
        const bool nonaff = __hip_atomic_load(&ctl[CW_NONAFF + 64 * b], RLX_AGENT) != 0u;
        const float lam = ld_f32_agent(LAM);
        if (G == 256) {
            att::unit(b, h, 63 - jj, PROJ, pos, nonaff, DTAB, BFAR, lam, subln_g, ACT, (char*)lds);
            att::unit(b, h, jj, PROJ, pos, nonaff, DTAB, BFAR, lam, subln_g, ACT, (char*)lds);
        }
    }
    xcd_barrier(bar);

    {
        pg8::DenseOrder S; S.init(ACT, WOUT, T, DM, DM, G, bx);
        pg8::EpiResid E{x, ADA + 2048, out};
        pg8::gemm_phase<pg8::EpiResid, pg8::DenseOrder, false>(L, DM, S, E);
    }
    xcd_barrier(bar);

    {
        LAS float* WT = (LAS float*)L;
        LAS int* lcnt = (LAS int*)(L + 81920);
        LAS int* lbase = (LAS int*)(L + 81920 + 64);
        LAS int* pe = (LAS int*)(L + 81920 + 128);
        for (int i = tid; i < 4096; i += 512) WT[(i & 3) * 1024 + (i >> 2)] = rgw[i];
        for (int i = tid; i < 16384; i += 512) WT[(4 + (i & 15)) * 1024 + (i >> 4)] = rew[i];
        if (tid < 16) lcnt[tid] = 0;
        __syncthreads();
        for (int blk = bx; blk < T / 64; blk += G) {
            const int lane = fresh_lane();
            for (int g = 0; g < 2; ++g) {
                const int row0 = blk * 64 + wave * 8 + g * 4; const int b = row0 / SEQ; const float* ad = ADA + b * 6144;
                f32x4 hv[4][4];
#pragma unroll
                for (int r = 0; r < 4; ++r) { const GAS f32x4* xr = (const GAS f32x4*)(out + (size_t)(row0 + r) * DM) + lane; float s = 0.f;
#pragma unroll
                    for (int jj = 0; jj < 4; ++jj) { hv[r][jj] = xr[64 * jj]; s += (hv[r][jj].x * hv[r][jj].x + hv[r][jj].y * hv[r][jj].y) + (hv[r][jj].z * hv[r][jj].z + hv[r][jj].w * hv[r][jj].w); }
                    const float rstd = rsqrtf(wave_sum(s) * (1.f / DM) + 1e-6f);
#pragma unroll
                    for (int jj = 0; jj < 4; ++jj) hv[r][jj] = hv[r][jj] * rstd; }
#pragma unroll
                for (int jj = 0; jj < 4; ++jj) { const int k = 4 * lane + 256 * jj;
                    const f32x4 gg = *(const f32x4*)(norm2_g + k), sh = *(const GAS f32x4*)(ad + 3072 + k), sc = *(const GAS f32x4*)(ad + 4096 + k);
#pragma unroll
                    for (int r = 0; r < 4; ++r) { const f32x4 y = hv[r][jj] * gg * (sc + 1.f) + sh; hv[r][jj] = y;
                        *((GAS unsigned long long*)(ACT + (size_t)(row0 + r) * DM) + lane + 64 * jj) = (unsigned long long)pk2(y.x, y.y) | ((unsigned long long)pk2(y.z, y.w) << 32); } }
                float acc[4][20];
#pragma unroll
                for (int r = 0; r < 4; ++r)
#pragma unroll
                    for (int q = 0; q < 20; ++q) acc[r][q] = 0.f;
#pragma unroll
                for (int jj = 0; jj < 4; ++jj)
#pragma unroll
                    for (int q = 0; q < 20; ++q) { const f32x4 wv = *(const LAS f32x4*)(WT + q * 1024 + 4 * lane + 256 * jj);
#pragma unroll
                        for (int r = 0; r < 4; ++r) acc[r][q] += (hv[r][jj].x * wv.x + hv[r][jj].y * wv.y) + (hv[r][jj].z * wv.z + hv[r][jj].w * wv.w); }
#pragma unroll
                for (int r = 0; r < 4; ++r)
#pragma unroll
                    for (int q = 0; q < 20; ++q) acc[r][q] = wave_sum(acc[r][q]);
                float lg[20];
#pragma unroll
                for (int q = 0; q < 20; ++q) lg[q] = (lane == 0) ? acc[0][q] : (lane == 1) ? acc[1][q] : (lane == 2) ? acc[2][q] : acc[3][q];
                if (lane < 4) {
                    const int row = row0 + lane;
                    float gl[4]; int gs = 0; float gm = -3.0e38f;
#pragma unroll
                    for (int q = 0; q < 4; ++q) { gl[q] = lg[q] + rgb[q]; if (gl[q] > gm) { gm = gl[q]; gs = q; } }
                    float den = 0.f;
#pragma unroll
                    for (int q = 0; q < 4; ++q) den += expf(gl[q] - gm);
                    const float pg = 1.f / den;
                    float el[4];
#pragma unroll
                    for (int q = 0; q < 4; ++q) { float v = 0.f;
#pragma unroll
                        for (int gq = 0; gq < 4; ++gq) v = (gq == gs) ? (lg[4 + gq * 4 + q] + reb[gq * 4 + q]) : v;
                        el[q] = v; }
                    int i0 = 0; float v0 = el[0];
#pragma unroll
                    for (int q = 1; q < 4; ++q) if (el[q] > v0) { v0 = el[q]; i0 = q; }
                    int i1 = 0; float v1 = -3.0e38f;
#pragma unroll
                    for (int q = 0; q < 4; ++q) if (q != i0 && el[q] > v1) { v1 = el[q]; i1 = q; }
                    const float e1 = expf(v1 - v0); const float w0 = pg / (1.f + e1), w1 = pg * e1 / (1.f + e1);
                    const int ex0 = gs * 4 + i0, ex1 = gs * 4 + i1;
                    TOKW[row * 2] = w0; TOKW[row * 2 + 1] = w1;
                    const int lt = (row - blk * 64) * 2;
                    const int rk0 = __hip_atomic_fetch_add(lcnt + ex0, 1, __ATOMIC_RELAXED, __HIP_MEMORY_SCOPE_WORKGROUP); const int rk1 = __hip_atomic_fetch_add(lcnt + ex1, 1, __ATOMIC_RELAXED, __HIP_MEMORY_SCOPE_WORKGROUP);
                    pe[lt] = ex0 | (rk0 << 8); pe[lt + 1] = ex1 | (rk1 << 8);
                }
            }
            __syncthreads();
            if (tid < 16) { const int n = lcnt[tid]; lbase[tid] = n ? (int)__hip_atomic_fetch_add(ctl + CW_CNT + 64 * tid, (unsigned)n, RLX_AGENT) : 0; }
            __syncthreads();
            if (tid < 128) { const int v = pe[tid], e = v & 255, rk = v >> 8; LIST[(size_t)e * T + lbase[e] + rk] = (blk * 64 + (tid >> 1)) * 2 + (tid & 1); }
            __syncthreads();
            if (tid < 16) lcnt[tid] = 0;
            __syncthreads();
        }
    }
    xcd_barrier(bar);

    {
        LAS int* tab = (LAS int*)(L + TAB_OFF);
        if (tid == 0) { int tp = 0;
            for (int e = 0; e < NE; ++e) { const int ce = (int)__hip_atomic_load(ctl + CW_CNT + 64 * e, RLX_AGENT); tab[e] = tp; tab[17 + e] = ce; tp += (ce + 255) >> 8; }
            tab[16] = tp; }
        __syncthreads();
        {
            MoeOrder<1> S; S.init(tab, G, vcu, ACT, WGU, LIST);
            pg8::EpiSwiglu E{HID};
            pg8::gemm_phase<pg8::EpiSwiglu, MoeOrder<1>, true>(L, DM, S, E);
        }
        xcd_barrier(bar);
        {
            MoeOrder<2> S; S.init(tab, G, vcu, HID, WD, LIST);
            pg8::EpiScatter E{Y, LIST, TOKW};
            pg8::gemm_phase<pg8::EpiScatter, MoeOrder<2>, true>(L, DE, S, E);
        }
    }
    xcd_barrier(bar);

    for (int row = gw; row < T; row += NGW) {
        const int lane = fresh_lane();
        const int b = row / SEQ; const float* g2 = ADA + b * 6144 + 5120;
        GAS f32x4* xr = (GAS f32x4*)(out + (size_t)row * DM) + lane;
        const GAS v2u* y0 = (const GAS v2u*)(Y + (size_t)row * DM) + lane; const GAS v2u* y1 = (const GAS v2u*)(Y + ((size_t)T + row) * DM) + lane;
        f32x4 v[4]; float s = 0.f;
#pragma unroll
        for (int jj = 0; jj < 4; ++jj) { const f32x4 xv = xr[64 * jj]; const v2u a = y0[64 * jj], c = y1[64 * jj]; const f32x4 gg = *(const GAS f32x4*)(g2 + 4 * lane + 256 * jj);
            f32x4 yv; yv.x = bf_lo(a.x) + bf_lo(c.x); yv.y = bf_hi(a.x) + bf_hi(c.x); yv.z = bf_lo(a.y) + bf_lo(c.y); yv.w = bf_hi(a.y) + bf_hi(c.y);
            v[jj] = xv + gg * yv; s += (v[jj].x * v[jj].x + v[jj].y * v[jj].y) + (v[jj].z * v[jj].z + v[jj].w * v[jj].w); }
        const float rstd = rsqrtf(wave_sum(s) * (1.f / DM) + 1e-6f);
#pragma unroll
        for (int jj = 0; jj < 4; ++jj) { const f32x4 fg = *(const f32x4*)(fing + 4 * lane + 256 * jj); xr[64 * jj] = v[jj] * rstd * fg; }
    }
}

extern "C" void kernel_launch(void* const* d_in, const int* in_sizes, int n_in, void* d_out, int out_size, void* d_ws, size_t ws_size, hipStream_t stream) {
    static int grid = 0;
    if (grid == 0) {
        if (n_in != 24 || out_size != T * DM || ws_size < WS_END) { fprintf(stderr, "kernel_launch: unexpected shapes (n_in %d out %d ws %zu)\n", n_in, out_size, ws_size); grid = -1; return; }
        int dev = 0, cus = 0, per_cu = 0;
        if (hipGetDevice(&dev) != hipSuccess || hipDeviceGetAttribute(&cus, hipDeviceAttributeMultiprocessorCount, dev) != hipSuccess) { grid = -1; return; }
        if (hipFuncSetAttribute((const void*)mk_fwd, hipFuncAttributeMaxDynamicSharedMemorySize, LDS_BYTES) != hipSuccess) { fprintf(stderr, "kernel_launch: hipFuncSetAttribute failed\n"); grid = -1; return; }
        if (hipOccupancyMaxActiveBlocksPerMultiprocessor(&per_cu, (const void*)mk_fwd, 512, LDS_BYTES) != hipSuccess || per_cu < 1) fprintf(stderr, "kernel_launch: occupancy query says %d\n", per_cu);
        (void)hipGetLastError();
        grid = cus;
        if (grid != 256) fprintf(stderr, "kernel_launch: %d CUs (built for 256)\n", grid);
    }
    if (grid < 0) return;
    if (hipMemsetAsync((char*)d_ws + WS_CTL, 0, CTL_ZERO_BYTES, stream) != hipSuccess) return;
    Args a{};
    for (int i = 0; i < 24; ++i) a.in[i] = d_in[i];
    a.out = (float*)d_out; a.ws = (unsigned char*)d_ws;
    hipLaunchKernelGGL(mk_fwd, dim3(grid), dim3(512), LDS_BYTES, stream, a);
}
```

```cpp
#include <hip/hip_runtime.h>
#include <cstdio>
#include <cstdint>
#include <cmath>

constexpr int BATCH = 2, SEQ = 8192, DM = 1024, T = BATCH * SEQ, NPROJ = 3072, NE = 16, DE = 512;
constexpr float LOG2E = 1.4426950408889634f;
constexpr float C2 = 0.125f * LOG2E;

constexpr size_t MiB = 1u << 20;
constexpr size_t WS_CTL = 0, CTL_ZERO_BYTES = 1 * MiB;
constexpr size_t WS_WIN = 2 * MiB;
constexpr size_t WS_WOUT = 8 * MiB;
constexpr size_t WS_WGU = 10 * MiB;
constexpr size_t WS_WD = 42 * MiB;
constexpr size_t WS_SMALL = 58 * MiB;
constexpr size_t WS_LIST = 60 * MiB;
constexpr size_t WS_TOKW = 61 * MiB;
constexpr size_t WS_ACT = 64 * MiB;
constexpr size_t WS_PROJ = 96 * MiB;
constexpr size_t WS_Y = 192 * MiB;
constexpr size_t WS_END = 256 * MiB;
constexpr int CW_NONAFF = 64;
constexpr int CW_CNT = 1024;
constexpr int CW_BAR = 4096;

constexpr int RING_BYTES = 131072;
constexpr int LDSCTL_OFF = 135168, MISC_OFF = LDSCTL_OFF + 320, TAB_OFF = LDSCTL_OFF + 512;
constexpr int LDS_BYTES = 147456;

#define GAS __attribute__((address_space(1)))
#define LAS __attribute__((address_space(3)))
typedef unsigned short bf16;
typedef unsigned v4u __attribute__((ext_vector_type(4)));
typedef unsigned v2u __attribute__((ext_vector_type(2)));
typedef float f32x4 __attribute__((ext_vector_type(4)));
typedef float f32x2 __attribute__((ext_vector_type(2)));
typedef float f32x16 __attribute__((ext_vector_type(16)));
typedef short bf16x8 __attribute__((ext_vector_type(8)));
typedef short s16x4 __attribute__((ext_vector_type(4)));
#define RLX_AGENT __ATOMIC_RELAXED, __HIP_MEMORY_SCOPE_AGENT
#define LDS_WAIT() asm volatile("s_waitcnt lgkmcnt(0)" ::: "memory")
#define VM_WAIT() asm volatile("s_waitcnt vmcnt(0)" ::: "memory")
__device__ __forceinline__ unsigned f2bf(float f) { unsigned u = __builtin_bit_cast(unsigned, f); return (u + 0x7fffu + ((u >> 16) & 1u)) >> 16; }
__device__ __forceinline__ unsigned pk2(float lo, float hi) { return f2bf(lo) | (f2bf(hi) << 16); }
__device__ __forceinline__ float bf_lo(unsigned w) { return __builtin_bit_cast(float, w << 16); }
__device__ __forceinline__ float bf_hi(unsigned w) { return __builtin_bit_cast(float, w & 0xffff0000u); }
__device__ __forceinline__ float ld_f32_agent(const float* p) { return __builtin_bit_cast(float, __hip_atomic_load((const unsigned*)p, RLX_AGENT)); }
__device__ __forceinline__ int ld_i32_agent(const int* p) { return (int)__hip_atomic_load((const unsigned*)p, RLX_AGENT); }

__device__ __forceinline__ int opaque_tid() { int t = (int)threadIdx.x; asm volatile("" : "+v"(t)); return t; }
#define XB_TMO      128
#define XB_XCNT(j)  (256  + 64 * (j))
#define XB_XSUB(j)  (1280 + 64 * (j))
#define XB_XGEN(j)  (2304 + 64 * (j))
#define XB_TOP      3328
#define XB_TOPGEN   3392
#define XCD_BAR_WORDS 3456
#define XB_SPIN_CAP (1u << 18)
__device__ __forceinline__ unsigned xb_ld(unsigned* p)              { return __hip_atomic_load(p, __ATOMIC_RELAXED, __HIP_MEMORY_SCOPE_AGENT); }
__device__ __forceinline__ unsigned xb_add(unsigned* p, unsigned v) { return __hip_atomic_fetch_add(p, v, __ATOMIC_RELAXED, __HIP_MEMORY_SCOPE_AGENT); }
__device__ __forceinline__ unsigned xb_xcc_id() { return (unsigned)__builtin_amdgcn_s_getreg((3 << 11) | 20) & 0xFu; }
#define XB_SPIN(cond, bar) do { unsigned _sp = 0; while (cond) { __builtin_amdgcn_s_sleep(1); \
    if ((++_sp & 255u) == 0u) { if (xb_ld(&(bar)[XB_TMO])) break; if (_sp > XB_SPIN_CAP) { atomicAdd(&(bar)[XB_TMO], 1u); break; } } } } while (0)
struct XcdBarrier { unsigned* bar; unsigned x; volatile LAS unsigned* st; };
__device__ __forceinline__ XcdBarrier xcd_barrier_post(unsigned* bar, volatile LAS unsigned* st) {
    XcdBarrier b; b.bar = bar; b.x = xb_xcc_id(); b.st = st;
    if (threadIdx.x == 0) (void)xb_add(&bar[XB_XCNT(b.x)], 1u);
    return b;
}
__device__ __forceinline__ void xcd_barrier_complete(unsigned* bar, unsigned x, unsigned& nloc, unsigned& nx) {
    const unsigned G = gridDim.x * gridDim.y * gridDim.z;
    unsigned sum, cnt, mine, sp = 0u;
    for (;;) {
        sum = 0u; cnt = 0u; mine = 0u;
#pragma unroll
        for (unsigned j = 0; j < 16; ++j) { const unsigned c = xb_ld(&bar[XB_XCNT(j)]); sum += c; cnt += (c > 0u) ? 1u : 0u; mine = (j == x) ? c : mine; }
        if (sum == G) break;
        __builtin_amdgcn_s_sleep(1);
        if ((++sp & 255u) == 0u) { if (xb_ld(&bar[XB_TMO])) break; if (sp > XB_SPIN_CAP) { atomicAdd(&bar[XB_TMO], 1u); break; } }
    }
    nloc = mine > 0u ? mine : 1u; nx = cnt > 0u ? cnt : 1u;
}
__device__ __forceinline__ void xcd_barrier(const XcdBarrier& b) {
    asm volatile("s_waitcnt vmcnt(0)" ::: "memory");
    __syncthreads();
    if (threadIdx.x == 0) {
        unsigned* bar = b.bar;
        __builtin_amdgcn_s_waitcnt(0);
        unsigned nloc = b.st[0], nx = b.st[1];
        if (nloc == 0u) { xcd_barrier_complete(bar, b.x, nloc, nx); b.st[0] = nloc; b.st[1] = nx; }
        const unsigned old = xb_add(&bar[XB_XSUB(b.x)], 1u);
        const unsigned gen = old / nloc;
        if (old + 1u == (gen + 1u) * nloc) {
            __builtin_amdgcn_fence(__ATOMIC_RELEASE, "agent");
            asm volatile("s_waitcnt vmcnt(0)" ::: "memory");
            const unsigned og = xb_add(&bar[XB_TOP], 1u);
            const unsigned tg = og / nx;
            if (og + 1u == (tg + 1u) * nx) xb_add(&bar[XB_TOPGEN], 1u);
            else XB_SPIN(xb_ld(&bar[XB_TOPGEN]) == tg, bar);
            __builtin_amdgcn_fence(__ATOMIC_ACQUIRE, "agent");
            xb_add(&bar[XB_XGEN(b.x)], 1u);
            asm volatile("s_waitcnt vmcnt(0)" ::: "memory");
        } else {
            XB_SPIN(xb_ld(&bar[XB_XGEN(b.x)]) == gen, bar);
            __builtin_amdgcn_fence(__ATOMIC_ACQUIRE, "agent");
            asm volatile("s_waitcnt vmcnt(0)" ::: "memory");
        }
    }
    __syncthreads();
}

namespace pg8 {
constexpr int BM = 256, BK = 64, HALF = 128, HTB = HALF * BK * 2, STAGE_BYTES = 8 * HTB, NXCD = 8, WGM = 8;
__host__ __device__ __forceinline__ int lds_byte(int r, int c) { const int st = (r >> 4) * 2 + (c >> 5), rr = r & 15, cc = c & 31, ob = rr * 64 + cc * 2; return st * 1024 + (ob ^ (((ob >> 9) & 1) << 5)); }
__host__ __device__ __forceinline__ void stage_rc(int b, int& R, int& C) { const int st = b / 1024, sb = b % 1024, swz = sb ^ (((sb >> 9) & 1) << 5); R = (st >> 1) * 16 + swz / 64; C = (st & 1) * 32 + (swz % 64) / 2; }
__host__ __device__ __forceinline__ int perm32(int rho) { const int n = rho >> 4, i = rho & 15; return 8 * (i >> 2) + 4 * n + (i & 3); }

struct Unit { const char* A; const char* B; unsigned ao00, ao01, ao10, ao11; int pm, pn, e, cnt, lr0; };

__device__ __forceinline__ unsigned cvt_pk_bf16(float lo, float hi) { unsigned r; asm volatile("v_cvt_pk_bf16_f32 %0, %1, %2" : "=v"(r) : "v"(lo), "v"(hi)); return r; }

struct DenseOrder {
    const char* A; const char* Bt; int K; int nM, nN, nwg, G, c; unsigned va0, va1;
    __device__ __forceinline__ void init(const void* A_, const void* Bt_, int M, int N, int K_, int G_, int c_) {
        A = (const char*)A_; Bt = (const char*)Bt_; K = K_; nM = M / BM; nN = N / BM; nwg = nM * nN; G = G_; c = c_;
        const int tq = opaque_tid(); int R, C; stage_rc(tq * 16, R, C); va0 = (unsigned)(R * K + C) * 2u; stage_rc(tq * 16 + 8192, R, C); va1 = (unsigned)(R * K + C) * 2u;
    }
    __device__ __forceinline__ bool next(int i, Unit& u) const {
        const long L = (long)i * G + c; if (L >= nwg) return false;
        int wgid = (int)L; { const int q = nwg / NXCD, r = nwg % NXCD, xcd = wgid % NXCD, off = wgid / NXCD; wgid = (xcd < r ? xcd * (q + 1) : r * (q + 1) + (xcd - r) * q) + off; }
        const int nig = WGM * nN, gid = wgid / nig, fm = gid * WGM, gsz = (nM - fm) < WGM ? (nM - fm) : WGM;
        u.pm = fm + ((wgid % nig) % gsz); u.pn = (wgid % nig) / gsz; u.e = 0; u.cnt = 0; u.lr0 = 0;
        const size_t tstep = (size_t)BM * K * 2; const unsigned hstep = (unsigned)HALF * K * 2;
        u.A = A + (size_t)u.pm * tstep; u.B = Bt + (size_t)u.pn * tstep;
        u.ao00 = va0; u.ao01 = va1; u.ao10 = va0 + hstep; u.ao11 = va1 + hstep; return true;
    }
};

struct EpiBf16 {
    static constexpr bool PERM = true;
    bf16* O; int ldc; int qcols; float qscale;
    __device__ __forceinline__ void operator()(const f32x4 (&acc)[2][2][4][2], const Unit& u, int wr, int wc, int fr, int fq) const {
        const int row0 = u.pm * BM + wr * 64 + fr; const int colt = u.pn * BM;
        const float sc = (colt < qcols) ? qscale : 1.f;
        const int col0 = colt + wc * 32 + 8 * fq;
#pragma unroll
        for (int ai = 0; ai < 2; ++ai)
#pragma unroll
            for (int m = 0; m < 4; ++m) { bf16* rowp = O + (size_t)(row0 + ai * HALF + m * 16) * ldc + col0;
#pragma unroll
                for (int bj = 0; bj < 2; ++bj) { const f32x4 v0 = acc[ai][bj][m][0] * sc, v1 = acc[ai][bj][m][1] * sc;
                    v4u w; w.x = cvt_pk_bf16(v0[0], v0[1]); w.y = cvt_pk_bf16(v0[2], v0[3]); w.z = cvt_pk_bf16(v1[0], v1[1]); w.w = cvt_pk_bf16(v1[2], v1[3]);
                    *(v4u*)(rowp + bj * HALF) = w; } }
    }
};
struct EpiResid {
    static constexpr bool PERM = false;
    const float* x; const float* gate; float* out;
    __device__ __forceinline__ void operator()(const f32x4 (&acc)[2][2][4][2], const Unit& u, int wr, int wc, int fr, int fq) const {
        const int row0 = u.pm * BM + wr * 64 + fr, col0 = u.pn * BM + wc * 32 + 4 * fq;
        const int b = (u.pm * BM) / SEQ;
        f32x4 gv[2][2];
#pragma unroll
        for (int bj = 0; bj < 2; ++bj)
#pragma unroll
            for (int n = 0; n < 2; ++n) gv[bj][n] = *(const GAS f32x4*)(gate + b * 6144 + col0 + bj * HALF + n * 16);
#pragma unroll
        for (int ai = 0; ai < 2; ++ai)
#pragma unroll
            for (int mp = 0; mp < 2; ++mp) {
                f32x4 xv[2][2][2];
#pragma unroll
                for (int mm = 0; mm < 2; ++mm) { const size_t off = (size_t)(row0 + ai * HALF + (2 * mp + mm) * 16) * DM + col0;
#pragma unroll
                    for (int bj = 0; bj < 2; ++bj)
#pragma unroll
                        for (int n = 0; n < 2; ++n) xv[mm][bj][n] = *(const f32x4*)(x + off + bj * HALF + n * 16); }
                asm volatile("" ::: "memory");
#pragma unroll
                for (int mm = 0; mm < 2; ++mm) { const size_t off = (size_t)(row0 + ai * HALF + (2 * mp + mm) * 16) * DM + col0;
#pragma unroll
                    for (int bj = 0; bj < 2; ++bj)
#pragma unroll
                        for (int n = 0; n < 2; ++n) *(f32x4*)(out + off + bj * HALF + n * 16) = xv[mm][bj][n] + gv[bj][n] * acc[ai][bj][2 * mp + mm][n]; }
                asm volatile("" ::: "memory");
            }
    }
};
struct EpiSwiglu {
    static constexpr bool PERM = true;
    bf16* hid;
    __device__ __forceinline__ void operator()(const f32x4 (&acc)[2][2][4][2], const Unit& u, int wr, int wc, int fr, int fq) const {
        const int row0 = u.pm * BM + wr * 64 + fr; const int col0 = u.pn * HALF + wc * 32 + 8 * fq;
#pragma unroll
        for (int ai = 0; ai < 2; ++ai)
#pragma unroll
            for (int m = 0; m < 4; ++m) { bf16* rowp = hid + (size_t)(row0 + ai * HALF + m * 16) * DE + col0;
                float o[8];
#pragma unroll
                for (int n = 0; n < 2; ++n)
#pragma unroll
                    for (int j = 0; j < 4; ++j) { const float g = acc[ai][0][m][n][j], up = acc[ai][1][m][n][j];
                        o[n * 4 + j] = g * __builtin_amdgcn_rcpf(1.f + __builtin_amdgcn_exp2f(-g * LOG2E)) * up; }
                v4u w; w.x = cvt_pk_bf16(o[0], o[1]); w.y = cvt_pk_bf16(o[2], o[3]); w.z = cvt_pk_bf16(o[4], o[5]); w.w = cvt_pk_bf16(o[6], o[7]);
                *(v4u*)rowp = w; }
    }
};
struct EpiScatter {
    static constexpr bool PERM = true;
    bf16* Y; const int* list; const float* tokw;
    __device__ __forceinline__ void operator()(const f32x4 (&acc)[2][2][4][2], const Unit& u, int wr, int wc, int fr, int fq) const {
        const int col0 = u.pn * BM + wc * 32 + 8 * fq; const int* le = list + (size_t)u.e * T;
        int ts[2][4]; float w[2][4];
#pragma unroll
        for (int ai = 0; ai < 2; ++ai)
#pragma unroll
            for (int m = 0; m < 4; ++m) { const int lr = u.lr0 + ai * HALF + wr * 64 + m * 16 + fr; ts[ai][m] = (lr < u.cnt) ? le[lr] : -1; }
#pragma unroll
        for (int ai = 0; ai < 2; ++ai)
#pragma unroll
            for (int m = 0; m < 4; ++m) w[ai][m] = (ts[ai][m] >= 0) ? tokw[ts[ai][m]] : 0.f;
        asm volatile("" ::: "memory");
#pragma unroll
        for (int ai = 0; ai < 2; ++ai)
#pragma unroll
            for (int m = 0; m < 4; ++m) {
                if (ts[ai][m] >= 0) {
                    bf16* rowp = Y + ((size_t)(ts[ai][m] & 1) * T + (size_t)(ts[ai][m] >> 1)) * DM + col0; const float ww = w[ai][m];
#pragma unroll
                    for (int bj = 0; bj < 2; ++bj) { const f32x4 v0 = acc[ai][bj][m][0] * ww, v1 = acc[ai][bj][m][1] * ww;
                        v4u o; o.x = cvt_pk_bf16(v0[0], v0[1]); o.y = cvt_pk_bf16(v0[2], v0[3]); o.z = cvt_pk_bf16(v1[0], v1[1]); o.w = cvt_pk_bf16(v1[2], v1[3]);
                        *(v4u*)(rowp + bj * HALF) = o; } } }
    }
};

template <class Epi, class Sched, bool ALIGN_EPI>
__device__ __forceinline__ void gemm_phase(LAS unsigned char* lds, const int K, const Sched& S, const Epi& E) {
    const int tid = opaque_tid(), wid = __builtin_amdgcn_readfirstlane(tid >> 6), lane = tid & 63, wr = wid >> 2, wc = wid & 3, fr = lane & 15, fq = lane >> 4;
    const int nt = K / BK;
    unsigned voffB[2];
#pragma unroll
    for (int i = 0; i < 2; ++i) { int R, C; stage_rc(tid * 16 + i * 8192, R, C); const int Rb = Epi::PERM ? ((R & ~31) + perm32(R & 31)) : R; voffB[i] = (unsigned)(Rb * K + C) * 2u; }
    const size_t kstep = (size_t)(BK * 2);
    const size_t hstep = (size_t)HALF * K * 2;
    const unsigned ldsw = (unsigned)wid * 1024u;
    const int aoff = lds_byte(wr * 64 + fr, fq * 8), boff = lds_byte(wc * 32 + fr, fq * 8);
#define PG8_SA(b, h) (((b) * 2 + (h)) * HTB)
#define PG8_SB(b, h) ((4 + (b) * 2 + (h)) * HTB)
#define PG8_STAGE(bufoff, gbase, voff) do { _Pragma("unroll") for (int _i = 0; _i < 2; ++_i) \
        __builtin_amdgcn_global_load_lds((const unsigned*)((const char*)(gbase) + (voff)[_i]), (LAS unsigned*)(lds + (bufoff) + ldsw + _i * 8192), 16, 0, 0); } while (0)
#define PG8_STAGEA(bufoff, gbase, o0, o1) do { \
        __builtin_amdgcn_global_load_lds((const unsigned*)((const char*)(gbase) + (o0)), (LAS unsigned*)(lds + (bufoff) + ldsw), 16, 0, 0); \
        __builtin_amdgcn_global_load_lds((const unsigned*)((const char*)(gbase) + (o1)), (LAS unsigned*)(lds + (bufoff) + ldsw + 8192), 16, 0, 0); } while (0)
#define PG8_LDA(dst, b, h) do { _Pragma("unroll") for (int m = 0; m < 4; ++m) _Pragma("unroll") for (int k = 0; k < 2; ++k) dst[m][k] = *(const LAS bf16x8*)(lds + PG8_SA(b, h) + aoff + m * 2048 + k * 1024); } while (0)
#define PG8_LDB(dst, b, h) do { _Pragma("unroll") for (int n = 0; n < 2; ++n) _Pragma("unroll") for (int k = 0; k < 2; ++k) dst[n][k] = *(const LAS bf16x8*)(lds + PG8_SB(b, h) + boff + n * 2048 + k * 1024); } while (0)
#define PG8_MMA(ai, bj, At, Bt) do { __builtin_amdgcn_s_setprio(1); _Pragma("unroll") for (int m = 0; m < 4; ++m) _Pragma("unroll") for (int n = 0; n < 2; ++n) _Pragma("unroll") for (int k = 0; k < 2; ++k) \
        acc[ai][bj][m][n] = __builtin_amdgcn_mfma_f32_16x16x32_bf16(Bt[n][k], At[m][k], acc[ai][bj][m][n], 0, 0, 0); __builtin_amdgcn_s_setprio(0); } while (0)
#define PG8_WAIT_V(n) asm volatile("s_waitcnt vmcnt(" #n ")" ::: "memory")
#define PG8_WAIT_L(n) asm volatile("s_waitcnt lgkmcnt(" #n ")" ::: "memory")
#define PG8_BAR __builtin_amdgcn_s_barrier()
#define PG8_SCHED __builtin_amdgcn_sched_barrier(0)
    Unit cur, nxt; int ui = 0;
    if (!S.next(0, cur)) return;
    f32x4 acc[2][2][4][2];
#pragma unroll
    for (int a = 0; a < 2; ++a)
#pragma unroll
        for (int b = 0; b < 2; ++b)
#pragma unroll
            for (int m = 0; m < 4; ++m)
#pragma unroll
                for (int n = 0; n < 2; ++n) acc[a][b][m][n] = (f32x4){0.f, 0.f, 0.f, 0.f};
    bf16x8 At[4][2], B0[2][2], B1[2][2];
    const char* cA = cur.A; const char* cB = cur.B;
    unsigned c00 = cur.ao00, c01 = cur.ao01, c10 = cur.ao10, c11 = cur.ao11;
    PG8_STAGE(PG8_SB(0, 0), cB, voffB); PG8_STAGE(PG8_SB(0, 1), cB + hstep, voffB); PG8_STAGEA(PG8_SA(0, 0), cA, c00, c01); PG8_STAGEA(PG8_SA(0, 1), cA, c10, c11);
    if (wr == 1) PG8_BAR;
    PG8_WAIT_V(2); PG8_BAR;
    PG8_STAGE(PG8_SB(1, 0), cB + kstep, voffB); PG8_STAGEA(PG8_SA(1, 0), cA + kstep, c00, c01); PG8_STAGE(PG8_SB(1, 1), cB + hstep + kstep, voffB);
    PG8_WAIT_V(6); PG8_BAR;
    for (;;) {
        const bool has_next = S.next(ui + 1, nxt);
        const char* nA = has_next ? nxt.A : cA; const char* nB = has_next ? nxt.B : cB;
        const unsigned n00 = has_next ? nxt.ao00 : c00, n01 = has_next ? nxt.ao01 : c01, n10 = has_next ? nxt.ao10 : c10, n11 = has_next ? nxt.ao11 : c11;
        for (int t = 0; t < nt; t += 2) {
            const bool last = (t == nt - 2);
            const char* a1 = cA + (size_t)(t + 1) * kstep;
            const char* a2 = last ? nA : cA + (size_t)(t + 2) * kstep; const char* b2 = last ? nB : cB + (size_t)(t + 2) * kstep;
            const char* a3 = a2 + kstep; const char* b3 = b2 + kstep;
            const unsigned o00 = last ? n00 : c00, o01 = last ? n01 : c01, o10 = last ? n10 : c10, o11 = last ? n11 : c11;
            PG8_LDB(B0, 0, 0); PG8_LDB(B1, 0, 1); PG8_SCHED; PG8_LDA(At, 0, 0); PG8_STAGEA(PG8_SA(1, 1), a1, c10, c11);
            PG8_WAIT_V(8); PG8_WAIT_L(0); PG8_BAR; PG8_MMA(0, 0, At, B0); PG8_MMA(0, 1, At, B1); PG8_BAR; PG8_SCHED;
            PG8_LDA(At, 0, 1); PG8_STAGE(PG8_SB(0, 0), b2, voffB); PG8_STAGE(PG8_SB(0, 1), b2 + hstep, voffB); PG8_STAGEA(PG8_SA(0, 0), a2, o00, o01);
            PG8_WAIT_V(8); PG8_WAIT_L(0); PG8_BAR; PG8_MMA(1, 0, At, B0); PG8_MMA(1, 1, At, B1); PG8_BAR; PG8_SCHED;
            PG8_LDB(B0, 1, 0); PG8_LDB(B1, 1, 1); PG8_SCHED; PG8_LDA(At, 1, 0); PG8_STAGEA(PG8_SA(0, 1), a2, o10, o11);
            PG8_WAIT_V(8); PG8_WAIT_L(0); PG8_BAR; PG8_MMA(0, 0, At, B0); PG8_MMA(0, 1, At, B1); PG8_BAR; PG8_SCHED;
            PG8_LDA(At, 1, 1); PG8_STAGE(PG8_SB(1, 0), b3, voffB); PG8_STAGE(PG8_SB(1, 1), b3 + hstep, voffB); PG8_STAGEA(PG8_SA(1, 0), a3, o00, o01);
            PG8_WAIT_V(8); PG8_WAIT_L(0); PG8_BAR; PG8_MMA(1, 0, At, B0); PG8_MMA(1, 1, At, B1); PG8_BAR; PG8_SCHED;
        }
        if constexpr (ALIGN_EPI) { if (wr == 0) PG8_BAR; }
        E(acc, cur, wr, wc, fr, fq);
        if (!has_next) break;
#pragma unroll
        for (int a = 0; a < 2; ++a)
#pragma unroll
            for (int b = 0; b < 2; ++b)
#pragma unroll
                for (int m = 0; m < 4; ++m)
#pragma unroll
                    for (int n = 0; n < 2; ++n) acc[a][b][m][n] = (f32x4){0.f, 0.f, 0.f, 0.f};
        cur = nxt; cA = nA; cB = nB; c00 = n00; c01 = n01; c10 = n10; c11 = n11; ++ui;
        if constexpr (ALIGN_EPI) { if (wr == 1) PG8_BAR; }
    }
    PG8_WAIT_V(0);
    if constexpr (!ALIGN_EPI) { if (wr == 0) PG8_BAR; }
    PG8_BAR;
#undef PG8_SA
#undef PG8_SB
#undef PG8_STAGE
#undef PG8_STAGEA
#undef PG8_LDA
#undef PG8_LDB
#undef PG8_MMA
#undef PG8_WAIT_V
#undef PG8_WAIT_L
#undef PG8_BAR
#undef PG8_SCHED
}
}

template <int WHICH>
struct MoeOrder {
    const LAS int* tab; int G, c, NU; const char* Abase; const char* Bbase; const int* list; unsigned va0, va1; int R0, R1, C0, C1;
    __device__ __forceinline__ void init(const LAS int* tab_, int G_, int c_, const void* A_, const void* B_, const int* list_) {
        tab = tab_; G = G_; c = c_; NU = 4 * tab_[16]; Abase = (const char*)A_; Bbase = (const char*)B_; list = list_;
        const int tq = opaque_tid(); pg8::stage_rc(tq * 16, R0, C0); pg8::stage_rc(tq * 16 + 8192, R1, C1);
        constexpr int K = (WHICH == 1) ? DM : DE;
        va0 = (unsigned)(R0 * K + C0) * 2u; va1 = (unsigned)(R1 * K + C1) * 2u;
    }
    __device__ __forceinline__ bool next(int i, pg8::Unit& u) const {
        const int uidx = i * G + c; if (uidx >= NU) return false;
        const int rtg = uidx >> 2, pn = uidx & 3;
        int e = 0;
#pragma unroll
        for (int k = 1; k < 16; ++k) e = (rtg >= tab[k]) ? k : e;
        const int rt = rtg - tab[e]; const int ce = tab[17 + e];
        u.pm = rtg; u.pn = pn; u.e = e; u.cnt = ce; u.lr0 = rt * 256;
        if (WHICH == 1) {
            const int* le = list + (size_t)e * T + rt * 256;
            const int r00 = rt * 256 + R0, r01 = rt * 256 + R1, r10 = r00 + 128, r11 = r01 + 128;
            const int t00 = (r00 < ce) ? (le[R0] >> 1) : 0, t01 = (r01 < ce) ? (le[R1] >> 1) : 0, t10 = (r10 < ce) ? (le[128 + R0] >> 1) : 0, t11 = (r11 < ce) ? (le[128 + R1] >> 1) : 0;
            u.A = Abase;
            u.ao00 = (unsigned)(t00 * DM + C0) * 2u; u.ao01 = (unsigned)(t01 * DM + C1) * 2u; u.ao10 = (unsigned)(t10 * DM + C0) * 2u; u.ao11 = (unsigned)(t11 * DM + C1) * 2u;
            u.B = Bbase + (size_t)e * (DM * DM * 2) + (size_t)pn * (256 * DM * 2);
        } else {
            u.A = Abase + (size_t)rtg * (256 * DE * 2);
            u.ao00 = va0; u.ao01 = va1; u.ao10 = va0 + 128 * DE * 2; u.ao11 = va1 + 128 * DE * 2;
            u.B = Bbase + (size_t)e * (DM * DE * 2) + (size_t)pn * (256 * DE * 2);
        }
        return true;
    }
};

namespace att {
constexpr int PITCH = NPROJ;
constexpr int KSLOT = 16384, VSLOT = 16384;
constexpr int L_K = 0, L_V = 4 * KSLOT, L_WS = L_V + 4 * VSLOT, L_DT = L_WS + 8 * 256, L_END = L_DT + 2 * 512;
constexpr int L_STASH = 0, L_STAGE = 65536;
constexpr float THR = 8.f;
typedef LAS const char* lds_cptr;
typedef short v4i16_t __attribute__((ext_vector_type(4)));
__device__ __forceinline__ int crow(int r, int hi) { return (r & 3) + 8 * (r >> 2) + 4 * hi; }
__device__ __forceinline__ void glds16(const void* gsrc, unsigned lds_dst) { unsigned keep;
    asm volatile("s_mov_b32 %0, m0\n\ts_mov_b32 m0, %2\n\ts_nop 0\n\tglobal_load_lds_dwordx4 %1, off\n\ts_mov_b32 m0, %0" : "=&s"(keep) : "v"(gsrc), "s"(lds_dst) : "memory"); }
__device__ __forceinline__ unsigned cvtpk(float lo, float hi) { typedef __bf16 bf16x2_t __attribute__((ext_vector_type(2))); f32x2 v = {lo, hi}; bf16x2_t b = __builtin_convertvector(v, bf16x2_t); return __builtin_bit_cast(unsigned, b); }
__device__ __forceinline__ s16x4 vtr(lds_cptr p) { return __builtin_bit_cast(s16x4, __builtin_amdgcn_ds_read_tr16_b64_v4i16((LAS v4i16_t*)p)); }
#define MX3(a, b, c) __builtin_fmaxf(__builtin_fmaxf((a), (b)), (c))
__device__ __forceinline__ float rowmax16(const f32x16& p) {
    float a = MX3(p[0], p[1], p[2]), b = MX3(p[3], p[4], p[5]); a = MX3(a, p[6], p[7]); b = MX3(b, p[8], p[9]); a = MX3(a, p[10], p[11]); b = MX3(b, p[12], p[13]); a = MX3(a, p[14], p[15]);
    float m = __builtin_fmaxf(a, b); auto rr = __builtin_amdgcn_permlane32_swap(__float_as_uint(m), __float_as_uint(m), false, false);
    return __builtin_fmaxf(__uint_as_float(rr[0]), __uint_as_float(rr[1])); }
#undef MX3
#define ATT_SBAR() __builtin_amdgcn_sched_barrier(0)
#define ATT_PIN(x) asm volatile("" : "+v"(x))
#define ATT_MFMA(a, b, c) __builtin_amdgcn_mfma_f32_32x32x16_bf16(a, b, c, 0, 0, 0)
#define ATT_EX(v) __builtin_amdgcn_exp2f(v)

template <int MODE> __device__ __forceinline__ void unit(const int b, const int h, const int j, const bf16* proj, const int* pos, const bool nonaff, const float* dtab, const float* bfar,
                                     const float lam, const float* subln_g, bf16* outp, char* shm) {
    const int tid = opaque_tid(), lane = tid & 63, r32 = lane & 31, hi = lane >> 5; const int wid = __builtin_amdgcn_readfirstlane(tid >> 6);
    const int m = wid >> 2, rg = wid & 3, comp = 2 * h + m;
    const long rowbase = (long)b * SEQ; const int q0 = j * 128, NT = 2 * j + 2;
    const unsigned lds0 = (unsigned)(uintptr_t)shm;
    float* wsf = (float*)(shm + L_WS) + wid * 64;
    float* dtl = (float*)(shm + L_DT) + m * 128;
    if (tid < 256) ((float*)(shm + L_DT))[tid] = dtab[(2 * h + (tid >> 7)) * 128 + (tid & 127)];
    const float bf = ld_f32_agent(bfar + comp);
    const bf16* Qw = proj + (rowbase + q0 + rg * 32) * PITCH + comp * 64;
    bf16x8 qr[4];
#pragma unroll
    for (int d0 = 0; d0 < 4; ++d0) qr[d0] = *reinterpret_cast<const bf16x8*>(&Qw[(long)r32 * PITCH + d0 * 16 + hi * 8]);
    const int qidx = q0 + rg * 32 + r32;
    int pq = pos[rowbase + qidx];
    asm volatile("" : "+v"(qr[0]), "+v"(qr[1]), "+v"(qr[2]), "+v"(qr[3]), "+v"(pq));
    __builtin_amdgcn_s_waitcnt(0x0F70);
    const bf16* k0src = proj + rowbase * PITCH + 512 + (2 * h) * 64 + (long)lane * PITCH + wid * 8;
    const bf16* k1src = k0src + 64;
    const bf16* v0src = proj + rowbase * PITCH + 1024 + h * 128 + (long)(16 * (wid & 3) + (lane >> 2)) * PITCH + (wid >> 2) * 32 + (lane & 3) * 8;
    const bf16* v1src = v0src + 64;
    const unsigned kdst = lds0 + L_K + wid * 1024, vdst = lds0 + L_V + wid * 1024;
#define ATT_DMA_K(t) do { if (MODE == 1) break; const long _o = (long)(t) * 64 * PITCH; const unsigned _d = kdst + ((t) & 3) * KSLOT; \
        glds16(k0src + _o, (unsigned)__builtin_amdgcn_readfirstlane(_d)); glds16(k1src + _o, (unsigned)__builtin_amdgcn_readfirstlane(_d + 8192)); } while (0)
#define ATT_DMA_V(t) do { if (MODE == 1) break; const long _o = (long)(t) * 64 * PITCH; const unsigned _d = vdst + ((t) & 3) * VSLOT; \
        glds16(v0src + _o, (unsigned)__builtin_amdgcn_readfirstlane(_d)); glds16(v1src + _o, (unsigned)__builtin_amdgcn_readfirstlane(_d + 8192)); } while (0)
    ATT_DMA_K(0); ATT_DMA_V(0); ATT_DMA_K(1); ATT_DMA_V(1);
    if (NT > 2) ATT_DMA_K(2);
    const lds_cptr shm3 = (lds_cptr)shm;
    const lds_cptr kp0 = shm3 + L_K + m * 8192 + hi * 1024 + r32 * 16;
    const lds_cptr vp0 = shm3 + L_V + ((lane >> 4) & 1) * 32 + (lane & 3) * 8 + (4 * hi + ((lane & 15) >> 2)) * 64;
    float mhat = 0.f, l_reg = 0.f;
    f32x16 o[4]; o[0] = f32x16{}; o[1] = f32x16{}; o[2] = f32x16{}; o[3] = f32x16{};
    f32x16 negm;
#pragma unroll
    for (int r = 0; r < 16; ++r) negm[r] = bf;
    f32x16 pA = f32x16{}, pB = f32x16{};
    bf16x8 kf[4];
    v4u pw0 = (v4u){0u, 0u, 0u, 0u}, pw1 = pw0;
    bool resc = false;
    s16x4 vl0, vh0, vl1, vh1, vl2, vh2, vl3, vh3;

#define ATT_KRD(jj, kbase) kf[jj] = *(const LAS bf16x8*)((kbase) + (jj) * 2048)
#define ATT_VRD(L_, H_, vb, i) do { L_ = vtr((vb) + ((i) & 3) * 4096 + ((i) >> 2) * 1024); H_ = vtr((vb) + ((i) & 3) * 4096 + ((i) >> 2) * 1024 + 512); } while (0)
#define ATT_VF(L_, H_) (bf16x8){L_[0], L_[1], L_[2], L_[3], H_[0], H_[1], H_[2], H_[3]}
#define ATT_PHASE_A(C, P, vbA) do { float sacc = P[0] + P[1]; \
        ATT_VRD(vl0, vh0, vbA, 0); C = ATT_MFMA(kf[0], qr[0], negm); sacc += P[2]; sacc += P[3]; sacc += P[4]; sacc += P[5]; ATT_PIN(sacc); pw0[0] = cvtpk(P[0], P[1]); pw0[1] = cvtpk(P[2], P[3]); ATT_PIN(pw0); ATT_SBAR(); \
        ATT_VRD(vl1, vh1, vbA, 1); C = ATT_MFMA(kf[1], qr[1], C);    sacc += P[6]; sacc += P[7]; sacc += P[8]; sacc += P[9]; ATT_PIN(sacc); pw0[2] = cvtpk(P[4], P[5]); pw0[3] = cvtpk(P[6], P[7]); ATT_PIN(pw0); ATT_SBAR(); \
        ATT_VRD(vl2, vh2, vbA, 2); C = ATT_MFMA(kf[2], qr[2], C);    sacc += P[10]; sacc += P[11]; sacc += P[12]; sacc += P[13]; ATT_PIN(sacc); pw1[0] = cvtpk(P[8], P[9]); pw1[1] = cvtpk(P[10], P[11]); ATT_PIN(pw1); ATT_SBAR(); \
        ATT_VRD(vl3, vh3, vbA, 3); C = ATT_MFMA(kf[3], qr[3], C);    sacc += P[14]; sacc += P[15]; ATT_PIN(sacc); pw1[2] = cvtpk(P[12], P[13]); pw1[3] = cvtpk(P[14], P[15]); ATT_PIN(pw1); ATT_SBAR(); \
        l_reg += sacc; } while (0)
#define ATT_PHASE_A0(C) do { C = ATT_MFMA(kf[0], qr[0], negm); C = ATT_MFMA(kf[1], qr[1], C); C = ATT_MFMA(kf[2], qr[2], C); C = ATT_MFMA(kf[3], qr[3], C); } while (0)
#define ATT_BAND(C, tt, hh) do { if (nonaff || (tt) >= NT - 4) { const int kb_ = 64 * (tt) + 32 * (hh) + 4 * hi; \
        _Pragma("unroll") for (int r = 0; r < 16; ++r) { const int kv_ = kb_ + (r & 3) + 8 * (r >> 2); \
            int d_ = nonaff ? (pq - pos[rowbase + kv_]) : (qidx - kv_); d_ = d_ < 0 ? 0 : (d_ > 127 ? 127 : d_); \
            const float t_ = dtl[d_]; C[r] = (kv_ > qidx) ? -INFINITY : C[r] + t_; } } } while (0)
#define ATT_MIDDLE(C, FIRST) do { const float rm_ = rowmax16(C); resc = false; \
        if (FIRST) { mhat = rm_; _Pragma("unroll") for (int r = 0; r < 16; ++r) { C[r] -= rm_; negm[r] = bf - mhat; } } \
        else if (__builtin_expect(__any(rm_ > THR), 0)) { const float dl_ = __builtin_fmaxf(rm_, 0.f); mhat += dl_; \
            _Pragma("unroll") for (int r = 0; r < 16; ++r) { C[r] -= dl_; negm[r] = bf - mhat; } \
            const float f_ = ATT_EX(-dl_); l_reg *= f_; if (hi == 0) wsf[r32] = f_; resc = true; } } while (0)
#define ATT_MX3(a, b, c) __builtin_fmaxf(__builtin_fmaxf((a), (b)), (c))
#define ATT_DECIDE(C, rm_) do { resc = false; \
        if (__builtin_expect(__any((rm_) > THR), 0)) { const float dl_ = __builtin_fmaxf((rm_), 0.f); mhat += dl_; \
            _Pragma("unroll") for (int r = 0; r < 16; ++r) { C[r] -= dl_; negm[r] = bf - mhat; } \
            const float f_ = ATT_EX(-dl_); l_reg *= f_; if (hi == 0) wsf[r32] = f_; resc = true; } } while (0)
#define ATT_PHASE_B(C, vb, kb, KR) do { float ma_, mb_, rm_; \
        o[0] = ATT_MFMA(__builtin_bit_cast(bf16x8, pw0), ATT_VF(vl0, vh0), o[0]); ATT_VRD(vl0, vh0, vb, 4); \
            ma_ = ATT_MX3(C[0], C[1], C[2]); mb_ = ATT_MX3(C[3], C[4], C[5]); ma_ = ATT_MX3(ma_, C[6], C[7]); mb_ = ATT_MX3(mb_, C[8], C[9]); ATT_PIN(ma_); ATT_PIN(mb_); ATT_SBAR(); \
        o[1] = ATT_MFMA(__builtin_bit_cast(bf16x8, pw0), ATT_VF(vl1, vh1), o[1]); ATT_VRD(vl1, vh1, vb, 5); if (KR) { ATT_KRD(0, kb); } \
            ma_ = ATT_MX3(ma_, C[10], C[11]); mb_ = ATT_MX3(mb_, C[12], C[13]); ma_ = ATT_MX3(ma_, C[14], C[15]); ma_ = __builtin_fmaxf(ma_, mb_); ATT_PIN(ma_); ATT_SBAR(); \
        o[2] = ATT_MFMA(__builtin_bit_cast(bf16x8, pw0), ATT_VF(vl2, vh2), o[2]); ATT_VRD(vl2, vh2, vb, 6); if (KR) { ATT_KRD(1, kb); } \
            { auto rr_ = __builtin_amdgcn_permlane32_swap(__float_as_uint(ma_), __float_as_uint(ma_), false, false); rm_ = __builtin_fmaxf(__uint_as_float(rr_[0]), __uint_as_float(rr_[1])); } ATT_PIN(rm_); ATT_SBAR(); \
        o[3] = ATT_MFMA(__builtin_bit_cast(bf16x8, pw0), ATT_VF(vl3, vh3), o[3]); ATT_VRD(vl3, vh3, vb, 7); if (KR) { ATT_KRD(2, kb); ATT_KRD(3, kb); } ATT_SBAR(); \
        ATT_DECIDE(C, rm_); ATT_SBAR(); \
        o[0] = ATT_MFMA(__builtin_bit_cast(bf16x8, pw1), ATT_VF(vl0, vh0), o[0]); C[0] = ATT_EX(C[0]); C[1] = ATT_EX(C[1]); C[2] = ATT_EX(C[2]); C[3] = ATT_EX(C[3]); ATT_PIN(C); ATT_SBAR(); \
        o[1] = ATT_MFMA(__builtin_bit_cast(bf16x8, pw1), ATT_VF(vl1, vh1), o[1]); C[4] = ATT_EX(C[4]); C[5] = ATT_EX(C[5]); C[6] = ATT_EX(C[6]); C[7] = ATT_EX(C[7]); ATT_PIN(C); ATT_SBAR(); \
        o[2] = ATT_MFMA(__builtin_bit_cast(bf16x8, pw1), ATT_VF(vl2, vh2), o[2]); C[8] = ATT_EX(C[8]); C[9] = ATT_EX(C[9]); C[10] = ATT_EX(C[10]); C[11] = ATT_EX(C[11]); ATT_PIN(C); ATT_SBAR(); \
        o[3] = ATT_MFMA(__builtin_bit_cast(bf16x8, pw1), ATT_VF(vl3, vh3), o[3]); C[12] = ATT_EX(C[12]); C[13] = ATT_EX(C[13]); C[14] = ATT_EX(C[14]); C[15] = ATT_EX(C[15]); ATT_PIN(C); ATT_SBAR(); } while (0)
#define ATT_PHASE_B0(C, kb) do { ATT_KRD(0, kb); ATT_KRD(1, kb); ATT_KRD(2, kb); ATT_KRD(3, kb); _Pragma("unroll") for (int r = 0; r < 16; ++r) C[r] = ATT_EX(C[r]); } while (0)
#define ATT_RESC() do { if (resc) { LDS_WAIT(); _Pragma("unroll") for (int r = 0; r < 16; ++r) { const float fr_ = wsf[crow(r, hi)]; \
        _Pragma("unroll") for (int dq = 0; dq < 4; ++dq) o[dq][r] *= fr_; } } } while (0)
#define ATT_WAIT_BAR(N) asm volatile("s_waitcnt vmcnt(" #N ") lgkmcnt(0)\n\ts_barrier" ::: "memory")

    if (NT > 2) { ATT_WAIT_BAR(2); } else { ATT_WAIT_BAR(0); }
    if (3 < NT) ATT_DMA_K(3);
    if (2 < NT) ATT_DMA_V(2);
    {
        const lds_cptr kb0 = kp0;
        ATT_KRD(0, kb0); ATT_KRD(1, kb0); ATT_KRD(2, kb0); ATT_KRD(3, kb0);
        ATT_PHASE_A0(pA); ATT_BAND(pA, 0, 0); ATT_MIDDLE(pA, true);
        ATT_PHASE_B0(pA, kp0 + 512);
        ATT_PHASE_A(pB, pA, vp0); ATT_BAND(pB, 0, 1);
        ATT_PHASE_B(pB, vp0, kp0 + KSLOT, true);
        ATT_RESC();
    }
    for (int t = 1; t < NT; ++t) {
        { const int pend = ((t + 2 < NT) ? 2 : 0) + ((t + 1 < NT) ? 2 : 0);
          if (pend == 4) { ATT_WAIT_BAR(4); } else if (pend == 2) { ATT_WAIT_BAR(2); } else { ATT_WAIT_BAR(0); } }
        if (t + 3 < NT) ATT_DMA_K(t + 3);
        if (t + 2 < NT) ATT_DMA_V(t + 2);
        const lds_cptr vprev = vp0 + ((t - 1) & 3) * VSLOT + 2048;
        const lds_cptr vcur = vp0 + (t & 3) * VSLOT;
        const lds_cptr kcur1 = kp0 + (t & 3) * KSLOT + 512;
        const lds_cptr knxt0 = kp0 + ((t + 1) & 3) * KSLOT;
        if (MODE != 2) {
        ATT_PHASE_A(pA, pB, vprev); ATT_BAND(pA, t, 0);
        ATT_PHASE_B(pA, vprev, kcur1, true);
        ATT_RESC();
        ATT_PHASE_A(pB, pA, vcur); ATT_BAND(pB, t, 1);
        ATT_PHASE_B(pB, vcur, knxt0, (t + 1 < NT));
        ATT_RESC();
        }
    }
    {
        float sacc = 0.f;
#pragma unroll
        for (int r = 0; r < 16; ++r) sacc += pB[r];
        l_reg += sacc;
#pragma unroll
        for (int q4 = 0; q4 < 4; ++q4) { pw0[q4] = cvtpk(pB[2 * q4], pB[2 * q4 + 1]); pw1[q4] = cvtpk(pB[8 + 2 * q4], pB[8 + 2 * q4 + 1]); }
        const lds_cptr vb = vp0 + ((NT - 1) & 3) * VSLOT + 2048;
#pragma unroll
        for (int i = 0; i < 8; ++i) { s16x4 lo, hi_; ATT_VRD(lo, hi_, vb, i);
            o[i & 3] = ATT_MFMA(__builtin_bit_cast(bf16x8, (i < 4) ? pw0 : pw1), ATT_VF(lo, hi_), o[i & 3]); }
    }
    { auto rr = __builtin_amdgcn_permlane32_swap(__float_as_uint(l_reg), __float_as_uint(l_reg), false, false); l_reg = __uint_as_float(rr[0]) + __uint_as_float(rr[1]); }
    if (hi == 0) wsf[32 + r32] = l_reg;
    LDS_WAIT();
    float rli[16];
#pragma unroll
    for (int r = 0; r < 16; ++r) rli[r] = __builtin_amdgcn_rcpf(wsf[32 + crow(r, hi)]);
    asm volatile("s_waitcnt lgkmcnt(0)\n\ts_barrier" ::: "memory");
    float* stash = (float*)(shm + L_STASH) + rg * 4096;
    if (m == 1) {
#pragma unroll
        for (int r = 0; r < 16; ++r)
#pragma unroll
            for (int dq = 0; dq < 4; ++dq) stash[crow(r, hi) * 128 + dq * 32 + r32] = lam * o[dq][r] * rli[r];
    }
    asm volatile("s_waitcnt lgkmcnt(0)\n\ts_barrier" ::: "memory");
    if (m == 0) {
        float ss[16];
#pragma unroll
        for (int r = 0; r < 16; ++r) { float s_ = 0.f;
#pragma unroll
            for (int dq = 0; dq < 4; ++dq) { const float dv = o[dq][r] * rli[r] - stash[crow(r, hi) * 128 + dq * 32 + r32]; o[dq][r] = dv; s_ += dv * dv; }
            ss[r] = s_; }
#pragma unroll
        for (int r = 0; r < 16; ++r) {
#pragma unroll
            for (int of = 1; of < 32; of <<= 1) ss[r] += __shfl_xor(ss[r], of);
            ss[r] = __builtin_amdgcn_rsqf(ss[r] * (1.f / 128.f) + 1e-5f) * 0.8f;
        }
        bf16* stg = (bf16*)(shm + L_STAGE) + rg * 4096;
        float gcol[4];
#pragma unroll
        for (int dq = 0; dq < 4; ++dq) gcol[dq] = subln_g[dq * 32 + r32];
#pragma unroll
        for (int r = 0; r < 16; ++r)
#pragma unroll
            for (int dq = 0; dq < 4; ++dq) stg[crow(r, hi) * 128 + dq * 32 + r32] = (bf16)f2bf(o[dq][r] * ss[r] * gcol[dq]);
        LDS_WAIT();
        bf16* Ow = outp + (rowbase + q0 + rg * 32) * DM + h * 128;
#pragma unroll
        for (int i = 0; i < 8; ++i) { const int row = i * 4 + (lane >> 4), ch = lane & 15; const v4u v = *(const v4u*)(stg + row * 128 + ch * 8); *(v4u*)(Ow + (long)row * DM + ch * 8) = v; }
    }
    asm volatile("s_waitcnt lgkmcnt(0)\n\ts_barrier" ::: "memory");
#undef ATT_DMA_K
#undef ATT_DMA_V
#undef ATT_KRD
#undef ATT_VRD
#undef ATT_VF
#undef ATT_PHASE_A
#undef ATT_PHASE_A0
#undef ATT_BAND
#undef ATT_MIDDLE
#undef ATT_MX3
#undef ATT_DECIDE
#undef ATT_PHASE_B
#undef ATT_PHASE_B0
#undef ATT_RESC
#undef ATT_WAIT_BAR
}
}

__device__ __forceinline__ int fresh_lane() { int l; asm volatile("v_mbcnt_lo_u32_b32 %0, -1, 0\n\tv_mbcnt_hi_u32_b32 %0, -1, %0" : "=v"(l)); return l; }
__device__ __forceinline__ float wave_sum(float v) {
#pragma unroll
    for (int o = 1; o < 64; o <<= 1) v += __shfl_xor(v, o);
    return v;
}
__device__ __forceinline__ void transpose_item(const float* W, int ldw, int k0, int n0, bf16* WT, int ldt, int drow0, LAS float* scr, int lane) {
#pragma unroll 8
    for (int i = 0; i < 32; ++i) { const int kk = 2 * i + (lane >> 5); scr[kk * 33 + (lane & 31)] = W[(size_t)(k0 + kk) * ldw + n0 + (lane & 31)]; }
    LDS_WAIT(); asm volatile("" ::: "memory");
    const int c = lane & 7;
#pragma unroll
    for (int j = 0; j < 4; ++j) { const int n = (lane >> 3) + 8 * j; const LAS float* s = scr + (8 * c) * 33 + n;
        v4u o; o.x = pk2(s[0 * 33], s[1 * 33]); o.y = pk2(s[2 * 33], s[3 * 33]); o.z = pk2(s[4 * 33], s[5 * 33]); o.w = pk2(s[6 * 33], s[7 * 33]);
        *(GAS v4u*)(WT + (size_t)(drow0 + n) * ldt + k0 + 8 * c) = o; }
    LDS_WAIT(); asm volatile("" ::: "memory");
}
__device__ __forceinline__ int rel_bucket(int n) {
    n = n < 0 ? 0 : n;
    if (n < 16) return n;
    int large = 16 + (int)(logf((float)n / 16.f) / 2.0794415416798357f * 16.f);
    return large < 31 ? large : 31;
}

struct Args { const void* in[24]; float* out; unsigned char* ws; };

__global__ void __launch_bounds__(512, 2) mk_fwd(Args args) {
    extern __shared__ __attribute__((aligned(16))) unsigned char lds[];
    LAS unsigned char* L = (LAS unsigned char*)lds;
    volatile LAS unsigned* MISC = (volatile LAS unsigned*)(L + MISC_OFF);
    const int tid = threadIdx.x, lane = tid & 63, wave = __builtin_amdgcn_readfirstlane(tid >> 6);
    const int G = gridDim.x, bx = blockIdx.x;
    const int vcu = (G % 8 == 0) ? (bx % 8) * (G / 8) + bx / 8 : bx;
    unsigned char* ws = args.ws;
    unsigned* ctl = (unsigned*)(ws + WS_CTL);
    const float* x = (const float*)args.in[0]; const float* cvec = (const float*)args.in[1]; const int* pos = (const int*)args.in[2];
    const float* rel_bias = (const float*)args.in[3]; const float* ada_w = (const float*)args.in[4]; const float* ada_b = (const float*)args.in[5];
    const float* norm1_g = (const float*)args.in[6]; const float* w_in = (const float*)args.in[7];
    const float* lq1 = (const float*)args.in[8]; const float* lk1 = (const float*)args.in[9]; const float* lq2 = (const float*)args.in[10]; const float* lk2 = (const float*)args.in[11];
    const float* subln_g = (const float*)args.in[12]; const float* conv_w = (const float*)args.in[13]; const float* w_out = (const float*)args.in[14];
    const float* norm2_g = (const float*)args.in[15]; const float* rgw = (const float*)args.in[16]; const float* rgb = (const float*)args.in[17];
    const float* rew = (const float*)args.in[18]; const float* reb = (const float*)args.in[19];
    const float* wg = (const float*)args.in[20]; const float* wu = (const float*)args.in[21]; const float* wd = (const float*)args.in[22]; const float* fing = (const float*)args.in[23];
    float* out = args.out;
    bf16* WIN = (bf16*)(ws + WS_WIN); bf16* WOUT = (bf16*)(ws + WS_WOUT); bf16* WGU = (bf16*)(ws + WS_WGU); bf16* WD = (bf16*)(ws + WS_WD);
    float* ADA = (float*)(ws + WS_SMALL); float* LAM = (float*)(ws + WS_SMALL + 65536); float* DTAB = (float*)(ws + WS_SMALL + 68 * 1024); float* BFAR = (float*)(ws + WS_SMALL + 72 * 1024);
    int* LIST = (int*)(ws + WS_LIST); float* TOKW = (float*)(ws + WS_TOKW);
    bf16* ACT = (bf16*)(ws + WS_ACT); bf16* PROJ = (bf16*)(ws + WS_PROJ); bf16* HID = (bf16*)(ws + WS_PROJ); bf16* Y = (bf16*)(ws + WS_Y);

    for (int u = tid; u < (LDS_BYTES - LDSCTL_OFF) / 4; u += 512) ((LAS unsigned*)(L + LDSCTL_OFF))[u] = 0u;
    __syncthreads();
    XcdBarrier bar = xcd_barrier_post(ctl + CW_BAR, MISC + 8);
    const int gw = vcu * 8 + wave, NGW = G * 8;

    {
        if (bx < 192) {
            LAS float* sc = (LAS float*)L;
            LAS float* red = (LAS float*)(L + 8192);
            for (int i = tid; i < 2048; i += 512) { const float v = cvec[i]; sc[i] = v / (1.f + __expf(-v)); }
            __syncthreads();
            const int kk = tid >> 5, jj = tid & 31, jcol = bx * 32 + jj;
            float a0 = 0.f, a1 = 0.f;
#pragma unroll 8
            for (int k = kk; k < 1024; k += 16) { const float wv = ada_w[(size_t)k * 6144 + jcol]; a0 += sc[k] * wv; a1 += sc[1024 + k] * wv; }
            red[(kk * 32 + jj) * 2] = a0; red[(kk * 32 + jj) * 2 + 1] = a1;
            __syncthreads();
            if (tid < 64) { const int j2 = tid & 31, b2 = tid >> 5; float s = 0.f;
#pragma unroll
                for (int q = 0; q < 16; ++q) s += red[(q * 32 + j2) * 2 + b2];
                ADA[b2 * 6144 + bx * 32 + j2] = s + ada_b[bx * 32 + j2]; }
            __syncthreads();
        } else if (bx == 192) {
            if (tid == 0) { float s1 = 0.f, s2 = 0.f; for (int i = 0; i < 64; ++i) { s1 += lq1[i] * lk1[i]; s2 += lq2[i] * lk2[i]; } LAM[0] = expf(s1) - expf(s2) + 0.2f; }
            for (int i = tid; i < 1024; i += 512) { const int c = i >> 7, d = i & 127; DTAB[i] = (rel_bias[rel_bucket(d) * 8 + c] - rel_bias[31 * 8 + c]) * LOG2E; }
            if (tid < 8) BFAR[tid] = rel_bias[31 * 8 + tid] * LOG2E;
        } else if (bx == 193) {
            for (int i = tid; i < BATCH * (SEQ - 1); i += 512) { const int b = i / (SEQ - 1), s = i % (SEQ - 1);
                if (pos[b * SEQ + s + 1] - pos[b * SEQ + s] != 1) atomicOr(&ctl[CW_NONAFF + 64 * b], 1u); }
        }
        LAS float* scr = (LAS float*)(L + wave * 16384);
        constexpr int I_IN = 16 * 96, I_OUT = 16 * 32, I_G = 16 * 16, I_D = 8 * 32, I_E = 2 * I_G + I_D;
        constexpr int NITEMS = I_IN + I_OUT + NE * I_E;
        for (int it = gw; it < NITEMS; it += NGW) {
            int r = it;
            if (r < I_IN) { const int kb = r / 96, nb = r % 96; transpose_item(w_in, NPROJ, kb * 64, nb * 32, WIN, DM, nb * 32, scr, lane); continue; } r -= I_IN;
            if (r < I_OUT) { const int kb = r / 32, nb = r % 32; transpose_item(w_out, DM, kb * 64, nb * 32, WOUT, DM, nb * 32, scr, lane); continue; } r -= I_OUT;
            const int e = r / I_E; r -= e * I_E;
            if (r < 2 * I_G) { const int up = r / I_G; r -= up * I_G; const int kb = r / 16, nb = r % 16, n0 = nb * 32;
                transpose_item((up ? wu : wg) + (size_t)e * DM * DE, DE, kb * 64, n0, WGU + (size_t)e * DM * DM, DM, (n0 >> 7) * 256 + (n0 & 127) + up * 128, scr, lane); continue; }
            r -= 2 * I_G; { const int kb = r / 32, nb = r % 32; transpose_item(wd + (size_t)e * DE * DM, DM, kb * 64, nb * 32, WD + (size_t)e * DM * DE, DE, nb * 32, scr, lane); }
        }
    }
    xcd_barrier(bar);

    for (int row = gw; row < T; row += NGW) {
        const int lane = fresh_lane();
        const int b = row / SEQ; const float* ad = ADA + b * 6144;
        const GAS f32x4* xr = (const GAS f32x4*)(x + (size_t)row * DM) + lane;
        f32x4 v[4]; float s = 0.f;
#pragma unroll
        for (int jj = 0; jj < 4; ++jj) { v[jj] = xr[64 * jj]; s += (v[jj].x * v[jj].x + v[jj].y * v[jj].y) + (v[jj].z * v[jj].z + v[jj].w * v[jj].w); }
        const float rstd = rsqrtf(wave_sum(s) * (1.f / DM) + 1e-6f);
        GAS unsigned long long* o8 = (GAS unsigned long long*)(ACT + (size_t)row * DM) + lane;
#pragma unroll
        for (int jj = 0; jj < 4; ++jj) { const int k = 4 * lane + 256 * jj;
            const f32x4 g = *(const f32x4*)(norm1_g + k), sh = *(const GAS f32x4*)(ad + k), sc = *(const GAS f32x4*)(ad + 1024 + k);
            const f32x4 y = v[jj] * rstd * g * (sc + 1.f) + sh;
            o8[64 * jj] = (unsigned long long)pk2(y.x, y.y) | ((unsigned long long)pk2(y.z, y.w) << 32); }
    }
    xcd_barrier(bar);

    {
        pg8::DenseOrder S; S.init(ACT, WIN, T, NPROJ, DM, G, bx);
        pg8::EpiBf16 E{PROJ, NPROJ, 512, C2};
        pg8::gemm_phase<pg8::EpiBf16, pg8::DenseOrder, true>(L, DM, S, E);
    }
    xcd_barrier(bar);

    {
        for (int it = (vcu * 512 + tid); it < T * 64; it += G * 512) {
            const int tk = it >> 6, c8 = (it & 63) * 8, s = tk % SEQ;
            const bf16* pr = PROJ + (size_t)tk * NPROJ;
            const v4u gb = *(const v4u*)(pr + 1536 + c8), gc0 = *(const v4u*)(pr + 2048 + c8), hc0 = *(const v4u*)(pr + 2560 + c8);
            v4u gc1 = (v4u){0, 0, 0, 0}, hc1 = gc1, gc2 = gc1, hc2 = gc1;
            if (s >= 1) { gc1 = *(const v4u*)(pr - NPROJ + 2048 + c8); hc1 = *(const v4u*)(pr - NPROJ + 2560 + c8); }
            if (s >= 2) { gc2 = *(const v4u*)(pr - 2 * NPROJ + 2048 + c8); hc2 = *(const v4u*)(pr - 2 * NPROJ + 2560 + c8); }
            const f32x4 w0a = *(const f32x4*)(conv_w + c8), w0b = *(const f32x4*)(conv_w + c8 + 4), w1a = *(const f32x4*)(conv_w + 512 + c8), w1b = *(const f32x4*)(conv_w + 512 + c8 + 4),
                        w2a = *(const f32x4*)(conv_w + 1024 + c8), w2b = *(const f32x4*)(conv_w + 1024 + c8 + 4);
            const float w0[8] = {w0a.x, w0a.y, w0a.z, w0a.w, w0b.x, w0b.y, w0b.z, w0b.w}, w1[8] = {w1a.x, w1a.y, w1a.z, w1a.w, w1b.x, w1b.y, w1b.z, w1b.w}, w2[8] = {w2a.x, w2a.y, w2a.z, w2a.w, w2b.x, w2b.y, w2b.z, w2b.w};
            v4u o;
#pragma unroll
            for (int q = 0; q < 4; ++q) {
                const float u0l = bf_lo(gc0[q]) * bf_lo(hc0[q]), u0h = bf_hi(gc0[q]) * bf_hi(hc0[q]);
                const float u1l = bf_lo(gc1[q]) * bf_lo(hc1[q]), u1h = bf_hi(gc1[q]) * bf_hi(hc1[q]);
                const float u2l = bf_lo(gc2[q]) * bf_lo(hc2[q]), u2h = bf_hi(gc2[q]) * bf_hi(hc2[q]);
                const float yl = bf_lo(gb[q]) * (w0[2 * q] * u2l + w1[2 * q] * u1l + w2[2 * q] * u0l);
                const float yh = bf_hi(gb[q]) * (w0[2 * q + 1] * u2h + w1[2 * q + 1] * u1h + w2[2 * q + 1] * u0h);
                o[q] = pk2(yl, yh);
            }
            *(v4u*)(ACT + (size_t)tk * DM + 512 + c8) = o;
        }
        VM_WAIT(); __syncthreads();
        const int bh = vcu >> 5, jj = vcu & 31, b = bh >> 2, h = bh & 3;
        const bool nonaff = __hip_atomic_load(&ctl[CW_NONAFF + 64 * b], RLX_AGENT) != 0u;
        const float lam = ld_f32_agent(LAM);
        if (G == 256) {
            att::unit<0>(b, h, 63 - jj, PROJ, pos, nonaff, DTAB, BFAR, lam, subln_g, ACT, (char*)lds);
            att::unit<0>(b, h, jj, PROJ, pos, nonaff, DTAB, BFAR, lam, subln_g, ACT, (char*)lds);
#ifdef PROBE_MODE
            att::unit<PROBE_MODE>(b, h, 63 - jj, PROJ, pos, nonaff, DTAB, BFAR, lam, subln_g, Y, (char*)lds);
            att::unit<PROBE_MODE>(b, h, jj, PROJ, pos, nonaff, DTAB, BFAR, lam, subln_g, Y, (char*)lds);
#endif
        }
    }
    xcd_barrier(bar);

    {
        pg8::DenseOrder S; S.init(ACT, WOUT, T, DM, DM, G, bx);
        pg8::EpiResid E{x, ADA + 2048, out};
        pg8::gemm_phase<pg8::EpiResid, pg8::DenseOrder, false>(L, DM, S, E);
    }
    xcd_barrier(bar);

    {
        LAS float* WT = (LAS float*)L;
        LAS int* lcnt = (LAS int*)(L + 81920);
        LAS int* lbase = (LAS int*)(L + 81920 + 64);
        LAS int* pe = (LAS int*)(L + 81920 + 128);
        for (int i = tid; i < 4096; i += 512) WT[(i & 3) * 1024 + (i >> 2)] = rgw[i];
        for (int i = tid; i < 16384; i += 512) WT[(4 + (i & 15)) * 1024 + (i >> 4)] = rew[i];
        if (tid < 16) lcnt[tid] = 0;
        __syncthreads();
        for (int blk = bx; blk < T / 64; blk += G) {
            const int lane = fresh_lane();
            for (int g = 0; g < 2; ++g) {
                const int row0 = blk * 64 + wave * 8 + g * 4; const int b = row0 / SEQ; const float* ad = ADA + b * 6144;
                f32x4 hv[4][4];
#pragma unroll
                for (int r = 0; r < 4; ++r) { const GAS f32x4* xr = (const GAS f32x4*)(out + (size_t)(row0 + r) * DM) + lane; float s = 0.f;
#pragma unroll
                    for (int jj = 0; jj < 4; ++jj) { hv[r][jj] = xr[64 * jj]; s += (hv[r][jj].x * hv[r][jj].x + hv[r][jj].y * hv[r][jj].y) + (hv[r][jj].z * hv[r][jj].z + hv[r][jj].w * hv[r][jj].w); }
                    const float rstd = rsqrtf(wave_sum(s) * (1.f / DM) + 1e-6f);
#pragma unroll
                    for (int jj = 0; jj < 4; ++jj) hv[r][jj] = hv[r][jj] * rstd; }
#pragma unroll
                for (int jj = 0; jj < 4; ++jj) { const int k = 4 * lane + 256 * jj;
                    const f32x4 gg = *(const f32x4*)(norm2_g + k), sh = *(const GAS f32x4*)(ad + 3072 + k), sc = *(const GAS f32x4*)(ad + 4096 + k);
#pragma unroll
                    for (int r = 0; r < 4; ++r) { const f32x4 y = hv[r][jj] * gg * (sc + 1.f) + sh; hv[r][jj] = y;
                        *((GAS unsigned long long*)(ACT + (size_t)(row0 + r) * DM) + lane + 64 * jj) = (unsigned long long)pk2(y.x, y.y) | ((unsigned long long)pk2(y.z, y.w) << 32); } }
                float acc[4][20];
#pragma unroll
                for (int r = 0; r < 4; ++r)
#pragma unroll
                    for (int q = 0; q < 20; ++q) acc[r][q] = 0.f;
#pragma unroll
                for (int jj = 0; jj < 4; ++jj)
#pragma unroll
                    for (int q = 0; q < 20; ++q) { const f32x4 wv = *(const LAS f32x4*)(WT + q * 1024 + 4 * lane + 256 * jj);
#pragma unroll
                        for (int r = 0; r < 4; ++r) acc[r][q] += (hv[r][jj].x * wv.x + hv[r][jj].y * wv.y) + (hv[r][jj].z * wv.z + hv[r][jj].w * wv.w); }
#pragma unroll
                for (int r = 0; r < 4; ++r)
#pragma unroll
                    for (int q = 0; q < 20; ++q) acc[r][q] = wave_sum(acc[r][q]);
                float lg[20];
#pragma unroll
                for (int q = 0; q < 20; ++q) lg[q] = (lane == 0) ? acc[0][q] : (lane == 1) ? acc[1][q] : (lane == 2) ? acc[2][q] : acc[3][q];
                if (lane < 4) {
                    const int row = row0 + lane;
                    float gl[4]; int gs = 0; float gm = -3.0e38f;
#pragma unroll
                    for (int q = 0; q < 4; ++q) { gl[q] = lg[q] + rgb[q]; if (gl[q] > gm) { gm = gl[q]; gs = q; } }
                    float den = 0.f;
#pragma unroll
                    for (int q = 0; q < 4; ++q) den += expf(gl[q] - gm);
                    const float pg = 1.f / den;
                    float el[4];
#pragma unroll
                    for (int q = 0; q < 4; ++q) { float v = 0.f;
#pragma unroll
                        for (int gq = 0; gq < 4; ++gq) v = (gq == gs) ? (lg[4 + gq * 4 + q] + reb[gq * 4 + q]) : v;
                        el[q] = v; }
                    int i0 = 0; float v0 = el[0];
#pragma unroll
                    for (int q = 1; q < 4; ++q) if (el[q] > v0) { v0 = el[q]; i0 = q; }
                    int i1 = 0; float v1 = -3.0e38f;
#pragma unroll
                    for (int q = 0; q < 4; ++q) if (q != i0 && el[q] > v1) { v1 = el[q]; i1 = q; }
                    const float e1 = expf(v1 - v0); const float w0 = pg / (1.f + e1), w1 = pg * e1 / (1.f + e1);
                    const int ex0 = gs * 4 + i0, ex1 = gs * 4 + i1;
                    TOKW[row * 2] = w0; TOKW[row * 2 + 1] = w1;
                    const int lt = (row - blk * 64) * 2;
                    const int rk0 = __hip_atomic_fetch_add(lcnt + ex0, 1, __ATOMIC_RELAXED, __HIP_MEMORY_SCOPE_WORKGROUP); const int rk1 = __hip_atomic_fetch_add(lcnt + ex1, 1, __ATOMIC_RELAXED, __HIP_MEMORY_SCOPE_WORKGROUP);
                    pe[lt] = ex0 | (rk0 << 8); pe[lt + 1] = ex1 | (rk1 << 8);
                }
            }
            __syncthreads();
            if (tid < 16) { const int n = lcnt[tid]; lbase[tid] = n ? (int)__hip_atomic_fetch_add(ctl + CW_CNT + 64 * tid, (unsigned)n, RLX_AGENT) : 0; }
            __syncthreads();
            if (tid < 128) { const int v = pe[tid], e = v & 255, rk = v >> 8; LIST[(size_t)e * T + lbase[e] + rk] = (blk * 64 + (tid >> 1)) * 2 + (tid & 1); }
            __syncthreads();
            if (tid < 16) lcnt[tid] = 0;
            __syncthreads();
        }
    }
    xcd_barrier(bar);

    {
        LAS int* tab = (LAS int*)(L + TAB_OFF);
        if (tid == 0) { int tp = 0;
            for (int e = 0; e < NE; ++e) { const int ce = (int)__hip_atomic_load(ctl + CW_CNT + 64 * e, RLX_AGENT); tab[e] = tp; tab[17 + e] = ce; tp += (ce + 255) >> 8; }
            tab[16] = tp; }
        __syncthreads();
        {
            MoeOrder<1> S; S.init(tab, G, vcu, ACT, WGU, LIST);
            pg8::EpiSwiglu E{HID};
            pg8::gemm_phase<pg8::EpiSwiglu, MoeOrder<1>, true>(L, DM, S, E);
        }
        xcd_barrier(bar);
        {
            MoeOrder<2> S; S.init(tab, G, vcu, HID, WD, LIST);
            pg8::EpiScatter E{Y, LIST, TOKW};
            pg8::gemm_phase<pg8::EpiScatter, MoeOrder<2>, true>(L, DE, S, E);
        }
    }
    xcd_barrier(bar);

    for (int row = gw; row < T; row += NGW) {
        const int lane = fresh_lane();
        const int b = row / SEQ; const float* g2 = ADA + b * 6144 + 5120;
        GAS f32x4* xr = (GAS f32x4*)(out + (size_t)row * DM) + lane;
        const GAS v2u* y0 = (const GAS v2u*)(Y + (size_t)row * DM) + lane; const GAS v2u* y1 = (const GAS v2u*)(Y + ((size_t)T + row) * DM) + lane;
        f32x4 v[4]; float s = 0.f;
#pragma unroll
        for (int jj = 0; jj < 4; ++jj) { const f32x4 xv = xr[64 * jj]; const v2u a = y0[64 * jj], c = y1[64 * jj]; const f32x4 gg = *(const GAS f32x4*)(g2 + 4 * lane + 256 * jj);
            f32x4 yv; yv.x = bf_lo(a.x) + bf_lo(c.x); yv.y = bf_hi(a.x) + bf_hi(c.x); yv.z = bf_lo(a.y) + bf_lo(c.y); yv.w = bf_hi(a.y) + bf_hi(c.y);
            v[jj] = xv + gg * yv; s += (v[jj].x * v[jj].x + v[jj].y * v[jj].y) + (v[jj].z * v[jj].z + v[jj].w * v[jj].w); }
        const float rstd = rsqrtf(wave_sum(s) * (1.f / DM) + 1e-6f);
#pragma unroll
        for (int jj = 0; jj < 4; ++jj) { const f32x4 fg = *(const f32x4*)(fing + 4 * lane + 256 * jj); xr[64 * jj] = v[jj] * rstd * fg; }
    }
}

extern "C" void kernel_launch(void* const* d_in, const int* in_sizes, int n_in, void* d_out, int out_size, void* d_ws, size_t ws_size, hipStream_t stream) {
    static int grid = 0;
    if (grid == 0) {
        if (n_in != 24 || out_size != T * DM || ws_size < WS_END) { fprintf(stderr, "kernel_launch: unexpected shapes (n_in %d out %d ws %zu)\n", n_in, out_size, ws_size); grid = -1; return; }
        int dev = 0, cus = 0, per_cu = 0;
        if (hipGetDevice(&dev) != hipSuccess || hipDeviceGetAttribute(&cus, hipDeviceAttributeMultiprocessorCount, dev) != hipSuccess) { grid = -1; return; }
        if (hipFuncSetAttribute((const void*)mk_fwd, hipFuncAttributeMaxDynamicSharedMemorySize, LDS_BYTES) != hipSuccess) { fprintf(stderr, "kernel_launch: hipFuncSetAttribute failed\n"); grid = -1; return; }
        if (hipOccupancyMaxActiveBlocksPerMultiprocessor(&per_cu, (const void*)mk_fwd, 512, LDS_BYTES) != hipSuccess || per_cu < 1) fprintf(stderr, "kernel_launch: occupancy query says %d\n", per_cu);
        (void)hipGetLastError();
        grid = cus;
        if (grid != 256) fprintf(stderr, "kernel_launch: %d CUs (built for 256)\n", grid);
    }
    if (grid < 0) return;
    if (hipMemsetAsync((char*)d_ws + WS_CTL, 0, CTL_ZERO_BYTES, stream) != hipSuccess) return;
    Args a{};
    for (int i = 0; i < 24; ++i) a.in[i] = d_in[i];
    a.out = (float*)d_out; a.ws = (unsigned char*)d_ws;
    hipLaunchKernelGGL(mk_fwd, dim3(grid), dim3(512), LDS_BYTES, stream, a);
}
```
